# Optimizing an MI355X kernel written in HIP

```python
import math
import jax, jax.numpy as jnp
from jax import lax
import numpy as np

D_MODEL = 1024
BATCH = 32
SEQ = 2048
DEPTH = 2

MEM_LEN = 256
CHUNK = 64
Q_BLOCK = 128
ROPE_THETA = 10000.0
EPS = 1e-6
NEG_BIG = -1e30

DIFF_HEADS = 8
DIFF_HD = 64
DIFF_VD = 2 * DIFF_HD
DIFF_W = DIFF_HEADS * DIFF_VD

LRU_W = D_MODEL
LRU_BLOCKS = 8
LRU_BW = LRU_W // LRU_BLOCKS
CONV_W = 4
RG_C = 8.0

XATTN_HEADS = 4
XATTN_HD = D_MODEL // XATTN_HEADS
XATTN_W = XATTN_HEADS * XATTN_HD

N_BRANCH = 3
D_FF = 4 * D_MODEL

IN_SPLITS = (
    2 * DIFF_HEADS * DIFF_HD,
    2 * DIFF_HEADS * DIFF_HD,
    DIFF_W,
    LRU_W,
    LRU_W,
    XATTN_W,
    N_BRANCH * D_MODEL,
)
N_IN = sum(IN_SPLITS)

kernel_name = 'hybrid_diffattn_rglru_memxattn_gated'


def rms_norm(x, g):
    xf = x.astype(jnp.float32)
    y = xf * lax.rsqrt(jnp.mean(xf * xf, axis=-1, keepdims=True) + EPS)
    return (y * g.astype(jnp.float32)).astype(x.dtype)


def in_projection(h, w):
    outs = []
    start = 0
    for n in IN_SPLITS:
        outs.append(h @ w[:, start:start + n])
        start += n
    return outs


def rope_tables(seq_len):
    half = DIFF_HD // 2
    pos = jnp.arange(seq_len, dtype=jnp.float32)
    inv = 1.0 / (ROPE_THETA ** (jnp.arange(half, dtype=jnp.float32) / half))
    ang = pos[:, None] * inv[None, :]
    return jnp.cos(ang), jnp.sin(ang)


def apply_rope(t, cos, sin):
    half = DIFF_HD // 2
    c = cos[:, None, None, :]
    s = sin[:, None, None, :]
    tf = t.astype(jnp.float32)
    t1, t2 = tf[..., :half], tf[..., half:]
    return jnp.concatenate([t1 * c - t2 * s, t2 * c + t1 * s], axis=-1).astype(t.dtype)


def diff_attention(q, k, v, lam, subln_g, lam_init):
    B, S = q.shape[0], q.shape[1]
    nq = S // Q_BLOCK
    scale = DIFF_HD ** -0.5
    qt = q.transpose(3, 0, 2, 1, 4)
    kt = k.transpose(3, 0, 2, 1, 4)
    k1, k2 = kt[0], kt[1]
    vt = v.transpose(0, 2, 1, 3)
    qblocks = qt.reshape(2, B, DIFF_HEADS, nq, Q_BLOCK, DIFF_HD).transpose(3, 0, 1, 2, 4, 5)
    key_chunk = jnp.arange(S) // CHUNK

    def block(args):
        qb, idx = args
        q_chunk = (idx * Q_BLOCK + jnp.arange(Q_BLOCK)) // CHUNK
        mask = key_chunk[None, :] <= q_chunk[:, None]
        s1 = jnp.einsum('bhqd,bhkd->bhqk', qb[0], k1).astype(jnp.float32) * scale
        s2 = jnp.einsum('bhqd,bhkd->bhqk', qb[1], k2).astype(jnp.float32) * scale
        p1 = jax.nn.softmax(jnp.where(mask, s1, NEG_BIG), axis=-1)
        p2 = jax.nn.softmax(jnp.where(mask, s2, NEG_BIG), axis=-1)
        p = p1 - lam * p2
        return jnp.einsum('bhqk,bhkv->bhqv', p.astype(vt.dtype), vt)

    out = lax.map(block, (qblocks, jnp.arange(nq)))
    out = out.transpose(1, 0, 3, 2, 4).reshape(B, S, DIFF_HEADS, DIFF_VD)
    out = rms_norm(out, subln_g) * (1.0 - lam_init)
    return out.reshape(B, S, DIFF_W)


def causal_conv(x, w, b):
    S = x.shape[1]
    xp = jnp.pad(x, ((0, 0), (CONV_W - 1, 0), (0, 0)))
    y = xp[:, 0:S] * w[0]
    for t in range(1, CONV_W):
        y = y + xp[:, t:t + S] * w[t]
    return y + b


def rg_lru(x, wa, ba, wi, bi, lam):
    B, S, W = x.shape
    xf = x.astype(jnp.float32)
    xb = xf.reshape(B, S, LRU_BLOCKS, LRU_BW)
    r = jax.nn.sigmoid(jnp.einsum('bsnc,ncd->bsnd', xb, wa.astype(jnp.float32)).reshape(B, S, W)
                       + ba.astype(jnp.float32))
    i = jax.nn.sigmoid(jnp.einsum('bsnc,ncd->bsnd', xb, wi.astype(jnp.float32)).reshape(B, S, W)
                       + bi.astype(jnp.float32))
    log_a = -RG_C * r * jax.nn.softplus(-lam.astype(jnp.float32))
    a = jnp.exp(log_a)
    u = jnp.sqrt(-jnp.expm1(2.0 * log_a)) * (i * xf)

    def combine(left, right):
        a_l, u_l = left
        a_r, u_r = right
        return a_l * a_r, a_r * u_l + u_r

    _, hs = lax.associative_scan(combine, (a, u), axis=1)
    return hs.astype(x.dtype)


def memory_attention(zq, mem, g_mem, w_kv):
    B, S = zq.shape[0], zq.shape[1]
    M = mem.shape[1]
    q = zq.reshape(B, S, XATTN_HEADS, XATTN_HD)
    kv = (rms_norm(mem, g_mem) @ w_kv).reshape(B, M, 2, XATTN_HEADS, XATTN_HD)
    s = jnp.einsum('bshd,bmhd->bhsm', q, kv[:, :, 0]).astype(jnp.float32) * (XATTN_HD ** -0.5)
    p = jax.nn.softmax(s, axis=-1)
    o = jnp.einsum('bhsm,bmhd->bshd', p.astype(q.dtype), kv[:, :, 1])
    return o.reshape(B, S, XATTN_W)


def setup_inputs(seed: int = 0) -> dict:
    key = jax.random.key(seed)
    ks = iter(jax.random.split(key, 40))
    f32 = jnp.float32

    def nrm(shape, scale):
        return jax.random.normal(next(ks), shape, f32) * scale

    def gain(shape):
        return 1.0 + 0.05 * jax.random.normal(next(ks), shape, f32)

    x = jax.random.normal(next(ks), (BATCH, SEQ, D_MODEL), f32)
    mem = jax.random.normal(next(ks), (BATCH, MEM_LEN, D_MODEL), f32)
    u = jax.random.uniform(next(ks), (DEPTH, LRU_W), f32, minval=0.9, maxval=0.999)
    a0 = u ** (1.0 / RG_C)
    rg_lambda = jnp.log(a0) - jnp.log1p(-a0)
    return {
        'x': x,
        'mem': mem,
        'norm_mix_pre': gain((DEPTH, D_MODEL)),
        'norm_mix_post': gain((DEPTH, D_MODEL)),
        'norm_mlp_pre': gain((DEPTH, D_MODEL)),
        'norm_mlp_post': gain((DEPTH, D_MODEL)),
        'norm_mem': gain((DEPTH, D_MODEL)),
        'w_in': nrm((DEPTH, D_MODEL, N_IN), D_MODEL ** -0.5),
        'b_gate': nrm((DEPTH, N_BRANCH, D_MODEL), 0.1),
        'lambda_q1': nrm((DEPTH, DIFF_HD), 0.1),
        'lambda_k1': nrm((DEPTH, DIFF_HD), 0.1),
        'lambda_q2': nrm((DEPTH, DIFF_HD), 0.1),
        'lambda_k2': nrm((DEPTH, DIFF_HD), 0.1),
        'diff_subln': gain((DEPTH, DIFF_VD)),
        'conv_w': nrm((DEPTH, CONV_W, LRU_W), CONV_W ** -0.5),
        'conv_b': nrm((DEPTH, LRU_W), 0.02),
        'rg_wa': nrm((DEPTH, LRU_BLOCKS, LRU_BW, LRU_BW), LRU_BW ** -0.5),
        'rg_ba': nrm((DEPTH, LRU_W), 0.1),
        'rg_wi': nrm((DEPTH, LRU_BLOCKS, LRU_BW, LRU_BW), LRU_BW ** -0.5),
        'rg_bi': nrm((DEPTH, LRU_W), 0.1),
        'rg_lambda': rg_lambda,
        'w_kv_mem': nrm((DEPTH, D_MODEL, 2 * XATTN_W), D_MODEL ** -0.5),
        'w_proj_attn': nrm((DEPTH, DIFF_W, D_MODEL), DIFF_W ** -0.5),
        'w_proj_lru': nrm((DEPTH, LRU_W, D_MODEL), LRU_W ** -0.5),
        'w_proj_mem': nrm((DEPTH, XATTN_W, D_MODEL), XATTN_W ** -0.5),
        'w_out': nrm((DEPTH, D_MODEL, D_MODEL), D_MODEL ** -0.5),
        'w_mlp_up': nrm((DEPTH, D_MODEL, D_FF), D_MODEL ** -0.5),
        'w_mlp_down': nrm((DEPTH, D_FF, D_MODEL), D_FF ** -0.5),
    }


def reference(x, mem, norm_mix_pre, norm_mix_post, norm_mlp_pre, norm_mlp_post, norm_mem,
              w_in, b_gate, lambda_q1, lambda_k1, lambda_q2, lambda_k2, diff_subln,
              conv_w, conv_b, rg_wa, rg_ba, rg_wi, rg_bi, rg_lambda, w_kv_mem,
              w_proj_attn, w_proj_lru, w_proj_mem, w_out, w_mlp_up, w_mlp_down):
    B, S, _ = x.shape
    cos, sin = rope_tables(S)
    for l in range(DEPTH):
        h = rms_norm(x, norm_mix_pre[l])
        zq, zk, zv, zx, zy, zxq, zg = in_projection(h, w_in[l])

        q = apply_rope(zq.reshape(B, S, DIFF_HEADS, 2, DIFF_HD), cos, sin)
        k = apply_rope(zk.reshape(B, S, DIFF_HEADS, 2, DIFF_HD), cos, sin)
        v = zv.reshape(B, S, DIFF_HEADS, DIFF_VD)
        lam_init = 0.8 - 0.6 * math.exp(-0.3 * l)
        lam = (jnp.exp(jnp.sum(lambda_q1[l].astype(jnp.float32) * lambda_k1[l].astype(jnp.float32)))
               - jnp.exp(jnp.sum(lambda_q2[l].astype(jnp.float32) * lambda_k2[l].astype(jnp.float32)))
               + lam_init)
        y_attn = diff_attention(q, k, v, lam, diff_subln[l], lam_init)

        xc = causal_conv(zx, conv_w[l], conv_b[l])
        y_lru = rg_lru(xc, rg_wa[l], rg_ba[l], rg_wi[l], rg_bi[l], rg_lambda[l]) * jax.nn.gelu(zy)

        y_mem = memory_attention(zxq, mem, norm_mem[l], w_kv_mem[l])

        gates = jax.nn.sigmoid(zg.reshape(B, S, N_BRANCH, D_MODEL) + b_gate[l])
        merged = (gates[:, :, 0] * (y_attn @ w_proj_attn[l])
                  + gates[:, :, 1] * (y_lru @ w_proj_lru[l])
                  + gates[:, :, 2] * (y_mem @ w_proj_mem[l]))
        x = x + rms_norm(merged @ w_out[l], norm_mix_post[l])

        h = rms_norm(x, norm_mlp_pre[l])
        a = jax.nn.relu(h @ w_mlp_up[l])
        x = x + rms_norm((a * a) @ w_mlp_down[l], norm_mlp_post[l])
    return x
```

```cpp
#include <hip/hip_runtime.h>
#include <hip/hip_cooperative_groups.h>
#include <cstdio>
#include <cstdint>
namespace cg = cooperative_groups;
namespace pg8 {
#define PG8_LAS __attribute__((address_space(3)))
typedef unsigned short bf16_t;
typedef short bf16x8 __attribute__((ext_vector_type(8)));
typedef float f32x4 __attribute__((ext_vector_type(4)));
typedef unsigned u32x4 __attribute__((ext_vector_type(4)));
constexpr int BM = 256, BK = 64, HALF = 128, HTB = HALF * BK * 2  , STAGE_BYTES = 8 * HTB, NXCD = 8, WGM = 8;

__host__ __device__ __forceinline__ int lds_byte(int r, int c) { const int st = (r >> 4) * 2 + (c >> 5), rr = r & 15, cc = c & 31, ob = rr * 64 + cc * 2; return st * 1024 + (ob ^ (((ob >> 9) & 1) << 5)); }
__host__ __device__ __forceinline__ void stage_rc(int b, int& R, int& C) { const int st = b / 1024, sb = b % 1024, swz = sb ^ (((sb >> 9) & 1) << 5); R = (st >> 1) * 16 + swz / 64; C = (st & 1) * 32 + (swz % 64) / 2; }
__host__ __device__ __forceinline__ int perm32(int rho) { const int n = rho >> 4, i = rho & 15; return 8 * (i >> 2) + 4 * n + (i & 3); }

struct Unit { int pm, pn; };
struct Gemm { const bf16_t* A; const bf16_t* Bt; int M, N, K; };

struct StaticOrder {
    int nM, nN, nwg, G, c;
    __host__ __device__ void init(int M, int N, int G_, int c_) { nM = M / BM; nN = N / BM; nwg = nM * nN; G = G_; c = c_; }
    __host__ __device__ bool next(int i, Unit& u) const {
        const long L = (long)i * G + c; if (L >= nwg) return false;
        int wgid = (int)L; { const int q = nwg / NXCD, r = nwg % NXCD, xcd = wgid % NXCD, off = wgid / NXCD; wgid = (xcd < r ? xcd * (q + 1) : r * (q + 1) + (xcd - r) * q) + off; }
        const int nig = WGM * nN, gid = wgid / nig, fm = gid * WGM, gsz = (nM - fm) < WGM ? (nM - fm) : WGM;
        u.pm = fm + ((wgid % nig) % gsz); u.pn = (wgid % nig) / gsz; return true;
    }
    __device__ __forceinline__ void a_ready(const Unit&) const {}
    __device__ __forceinline__ void done(const Unit&) const {}
};

typedef float f32x2c_t __attribute__((ext_vector_type(2))); typedef __bf16 bf16x2c_t __attribute__((ext_vector_type(2)));
__device__ __forceinline__ unsigned cvt_pk_bf16(float lo, float hi) { f32x2c_t v = {lo, hi}; bf16x2c_t b = __builtin_convertvector(v, bf16x2c_t); return __builtin_bit_cast(unsigned, b); }
typedef float f32x2 __attribute__((ext_vector_type(2)));
struct GemmB {
    const bf16_t* A; const bf16_t* B; int K, lda, ldb, b_div; long a_pm, a_pn, b_bs, b_pn;
    __device__ __forceinline__ const char* aptr(const Unit& u) const { return (const char*)(A + (long)u.pm * a_pm + (long)u.pn * a_pn); }
    __device__ __forceinline__ const char* bptr(const Unit& u) const { return (const char*)(B + (long)(u.pm / b_div) * b_bs + (long)u.pn * b_pn); }
};
__device__ __forceinline__ GemmB gemm_plain(const bf16_t* A, int lda, const bf16_t* B, int ldb, int K) { GemmB g; g.A = A; g.B = B; g.K = K; g.lda = lda; g.ldb = ldb; g.b_div = 1; g.a_pm = 256L * lda; g.a_pn = 0; g.b_bs = 0; g.b_pn = 256L * ldb; return g; }

__device__ __forceinline__ float bf_lo(unsigned w) { return __uint_as_float(w << 16); }
__device__ __forceinline__ float bf_hi(unsigned w) { return __uint_as_float(w & 0xffff0000u); }
__device__ __forceinline__ float sigmoidf_(float x) { return __builtin_amdgcn_rcpf(1.0f + __expf(-x)); }
__device__ __forceinline__ float gelu_tanh_(float x) { const float z = 1.5957691216057308f * (x + 0.044715f * x * x * x); return x * __builtin_amdgcn_rcpf(1.0f + __expf(-z)); }
__device__ __forceinline__ u32x4 pack8(const f32x4 a, const f32x4 b) { u32x4 w; w.x = cvt_pk_bf16(a[0], a[1]); w.y = cvt_pk_bf16(a[2], a[3]); w.z = cvt_pk_bf16(b[0], b[1]); w.w = cvt_pk_bf16(b[2], b[3]); return w; }

#define EPI_FOR_AI_M _Pragma("unroll") for (int ai = 0; ai < 2; ++ai) _Pragma("unroll") for (int m = 0; m < 4; ++m)
#define EPI_FOR_BJ _Pragma("unroll") for (int bj = 0; bj < 2; ++bj)

struct EpiPlain {
    static constexpr bool PERM = true, AFTER_DRAIN = false;
    bf16_t* O; long ldc; int mode; float scale;
    __device__ __forceinline__ void operator()(const f32x4 (&acc)[2][2][4][2], const Unit& u, int wr, int wc, int fr, int fq) const {
        const int row0 = u.pm * BM + wr * 64 + fr, col0 = u.pn * BM + wc * 32 + 8 * fq;
        EPI_FOR_AI_M { bf16_t* rowp = O + (long)(row0 + ai * HALF + m * 16) * ldc + col0;
            EPI_FOR_BJ { f32x4 v0 = acc[ai][bj][m][0], v1 = acc[ai][bj][m][1];
                if (mode == 1) {
#pragma unroll
                    for (int i = 0; i < 4; ++i) { const float a = fmaxf(v0[i], 0.f), b = fmaxf(v1[i], 0.f); v0[i] = a * a; v1[i] = b * b; }
                } else { v0 = v0 * scale; v1 = v1 * scale; }
                *(u32x4*)(rowp + bj * HALF) = pack8(v0, v1); } }
    }
};
struct EpiF32 {
    static constexpr bool PERM = true, AFTER_DRAIN = false;
    float* O; long ldc;
    __device__ __forceinline__ void operator()(const f32x4 (&acc)[2][2][4][2], const Unit& u, int wr, int wc, int fr, int fq) const {
        const int row0 = u.pm * BM + wr * 64 + fr, col0 = u.pn * BM + wc * 32 + 8 * fq;
        EPI_FOR_AI_M { float* rowp = O + (long)(row0 + ai * HALF + m * 16) * ldc + col0;
            EPI_FOR_BJ { *(f32x4*)(rowp + bj * HALF) = acc[ai][bj][m][0]; *(f32x4*)(rowp + bj * HALF + 4) = acc[ai][bj][m][1]; } }
    }
};
struct EpiInProj {
    static constexpr bool PERM = true, AFTER_DRAIN = false;
    bf16_t* z; long secsz; const float* cosT; const float* sinT; const float* bgate; float qscale;
    __device__ __forceinline__ void operator()(const f32x4 (&acc)[2][2][4][2], const Unit& u, int wr, int wc, int fr, int fq) const {
        const int sec = u.pn >> 2, row0 = u.pm * BM + wr * 64 + fr, col0 = (u.pn & 3) * BM + wc * 32 + 8 * fq;
        bf16_t* base = z + (long)sec * secsz;
        if (sec <= 1) {
            const float sc = sec == 0 ? qscale : 1.0f; const int dp = 16 * (wc & 1) + 4 * fq;
            EPI_FOR_AI_M { const int row = row0 + ai * HALF + m * 16, pos = row & 2047;
                const f32x4 c = *(const f32x4*)(cosT + pos * 32 + dp) * sc, s = *(const f32x4*)(sinT + pos * 32 + dp) * sc;
                EPI_FOR_BJ { const f32x4 v0 = acc[ai][bj][m][0], v1 = acc[ai][bj][m][1]; f32x4 o0, o1;
                    o0[0] = v0[0] * c[0] - v0[1] * s[0]; o0[1] = v0[1] * c[0] + v0[0] * s[0]; o0[2] = v0[2] * c[1] - v0[3] * s[1]; o0[3] = v0[3] * c[1] + v0[2] * s[1];
                    o1[0] = v1[0] * c[2] - v1[1] * s[2]; o1[1] = v1[1] * c[2] + v1[0] * s[2]; o1[2] = v1[2] * c[3] - v1[3] * s[3]; o1[3] = v1[3] * c[3] + v1[2] * s[3];
                    *(u32x4*)(base + (long)row * 1024 + col0 + bj * HALF) = pack8(o0, o1); } }
        } else if (sec >= 6) {
            const float* bg = bgate + (sec - 6) * 1024 + col0;
            EPI_FOR_BJ { const f32x4 b0 = *(const f32x4*)(bg + bj * HALF), b1 = *(const f32x4*)(bg + bj * HALF + 4);
                EPI_FOR_AI_M { f32x4 v0 = acc[ai][bj][m][0] + b0, v1 = acc[ai][bj][m][1] + b1;
#pragma unroll
                    for (int i = 0; i < 4; ++i) { v0[i] = sigmoidf_(v0[i]); v1[i] = sigmoidf_(v1[i]); }
                    *(u32x4*)(base + (long)(row0 + ai * HALF + m * 16) * 1024 + col0 + bj * HALF) = pack8(v0, v1); } }
        } else {
            const float sc = sec == 5 ? 0.0625f : 1.0f;
            EPI_FOR_AI_M { EPI_FOR_BJ { f32x4 v0 = acc[ai][bj][m][0] * sc, v1 = acc[ai][bj][m][1] * sc;
                    if (sec == 4) {
#pragma unroll
                        for (int i = 0; i < 4; ++i) { v0[i] = gelu_tanh_(v0[i]); v1[i] = gelu_tanh_(v1[i]); }
                    }
                    *(u32x4*)(base + (long)(row0 + ai * HALF + m * 16) * 1024 + col0 + bj * HALF) = pack8(v0, v1); } }
        }
    }
};
struct EpiGate {
    static constexpr bool PERM = true, AFTER_DRAIN = false;
    const bf16_t* xc; bf16_t* LA; bf16_t* U; const float* ba; const float* bi; const float* nsp;
    __device__ __forceinline__ void operator()(const f32x4 (&acc)[2][2][4][2], const Unit& u, int wr, int wc, int fr, int fq) const {
        typedef unsigned u32x2 __attribute__((ext_vector_type(2)));
        const int row0 = u.pm * BM + wr * 64 + fr, c0 = u.pn * HALF + wc * 32 + 8 * fq;
#pragma unroll
        for (int hf = 0; hf < 2; ++hf) {
            const f32x4 fba = *(const f32x4*)(ba + c0 + 4 * hf), fbi = *(const f32x4*)(bi + c0 + 4 * hf), fsp = *(const f32x4*)(nsp + c0 + 4 * hf);
            EPI_FOR_AI_M { const long off = (long)(row0 + ai * HALF + m * 16) * 1024 + c0 + 4 * hf;
                const u32x2 xw = *(const u32x2*)(xc + off); const f32x4 xv = {bf_lo(xw.x), bf_hi(xw.x), bf_lo(xw.y), bf_hi(xw.y)};
                f32x4 la, uu;
#pragma unroll
                for (int i = 0; i < 4; ++i) { const float r = sigmoidf_(acc[ai][0][m][hf][i] + fba[i]), ig = sigmoidf_(acc[ai][1][m][hf][i] + fbi[i]); const float l = r * fsp[i]; la[i] = l;
                    const float x2 = 2.0f * l; const float poly = -x2 * (1.0f + x2 * (0.5f + x2 * (0.16666667f + x2 * (0.041666668f + x2 * 0.0083333338f)))); const float om = x2 > -0.5f ? poly : 1.0f - __expf(x2);
                    uu[i] = sqrtf(fmaxf(om, 0.f)) * (ig * xv[i]); }
                u32x2 wl_, wu_; wl_.x = cvt_pk_bf16(la[0], la[1]); wl_.y = cvt_pk_bf16(la[2], la[3]); wu_.x = cvt_pk_bf16(uu[0], uu[1]); wu_.y = cvt_pk_bf16(uu[2], uu[3]);
                *(u32x2*)(LA + off) = wl_; *(u32x2*)(U + off) = wu_; asm volatile("" ::: "memory"); }
        }
    }
};
template <int STEP> struct EpiMerge {
    static constexpr bool PERM = true, AFTER_DRAIN = false;
    const bf16_t* gate; float* MF; bf16_t* MB;
    __device__ __forceinline__ void operator()(const f32x4 (&acc)[2][2][4][2], const Unit& u, int wr, int wc, int fr, int fq) const {
        const int row0 = u.pm * BM + wr * 64 + fr, col0 = u.pn * BM + wc * 32 + 8 * fq;
        EPI_FOR_AI_M { EPI_FOR_BJ { const long off = (long)(row0 + ai * HALF + m * 16) * 1024 + col0 + bj * HALF;
                const u32x4 gw = *(const u32x4*)(gate + off);
                const f32x4 g0 = {bf_lo(gw.x), bf_hi(gw.x), bf_lo(gw.y), bf_hi(gw.y)}, g1 = {bf_lo(gw.z), bf_hi(gw.z), bf_lo(gw.w), bf_hi(gw.w)};
                f32x4 v0 = acc[ai][bj][m][0] * g0, v1 = acc[ai][bj][m][1] * g1;
                if (STEP > 0) { v0 = v0 + *(const f32x4*)(MF + off); v1 = v1 + *(const f32x4*)(MF + off + 4); }
                if (STEP < 2) { *(f32x4*)(MF + off) = v0; *(f32x4*)(MF + off + 4) = v1; }
                else *(u32x4*)(MB + off) = pack8(v0, v1); } }
    }
};
template <class Epi, class GemmT, class Sched, bool ALIGN_EPI = true, bool SP2 = true>
__device__ __forceinline__ void gemm_phase(PG8_LAS unsigned char* lds, const GemmT g, const Sched& S, const Epi& E) {
    int tid = threadIdx.x; asm volatile("" : "+v"(tid));
    const int wid = __builtin_amdgcn_readfirstlane(tid >> 6), lane = tid & 63, wr = wid >> 2, wc = wid & 3, fr = lane & 15, fq = lane >> 4;
    int K = g.K; asm volatile("" : "+s"(K));
    const int nt = K / BK;
    unsigned voffA[2], voffB[2];
#pragma unroll
    for (int i = 0; i < 2; ++i) { int R, C; stage_rc(tid * 16 + i * 8192, R, C); const int Rb = Epi::PERM ? ((R & ~31) + perm32(R & 31)) : R;
        voffA[i] = (unsigned)(R * g.lda + C) * 2u; voffB[i] = (unsigned)(Rb * g.ldb + C) * 2u; }
    const size_t kstep = (size_t)(BK * 2);
    const size_t hstepA = (size_t)HALF * g.lda * 2, hstepB = (size_t)HALF * g.ldb * 2;
    const unsigned ldsw = (unsigned)wid * 1024u;
    const int aoff = lds_byte(wr * 64 + fr, fq * 8), boff = lds_byte(wc * 32 + fr, fq * 8);
#define PG8_SA(b, h) (((b) * 2 + (h)) * HTB)
#define PG8_SB(b, h) ((4 + (b) * 2 + (h)) * HTB)
#define PG8_STAGE(bufoff, gbase, voff) do { _Pragma("unroll") for (int _i = 0; _i < 2; ++_i) \
        __builtin_amdgcn_global_load_lds((const unsigned*)((const char*)(gbase) + (voff)[_i]), (PG8_LAS unsigned*)(lds + (bufoff) + ldsw + _i * 8192), 16, 0, 0); } while (0)
#define PG8_LDA(dst, b, h) do { _Pragma("unroll") for (int m = 0; m < 4; ++m) _Pragma("unroll") for (int k = 0; k < 2; ++k) dst[m][k] = *(const PG8_LAS bf16x8*)(lds + PG8_SA(b, h) + aoff + m * 2048 + k * 1024); } while (0)
#define PG8_LDB(dst, b, h) do { _Pragma("unroll") for (int n = 0; n < 2; ++n) _Pragma("unroll") for (int k = 0; k < 2; ++k) dst[n][k] = *(const PG8_LAS bf16x8*)(lds + PG8_SB(b, h) + boff + n * 2048 + k * 1024); } while (0)
#define PG8_MMA(ai, bj, At, Bt) do { __builtin_amdgcn_s_setprio(1); _Pragma("unroll") for (int m = 0; m < 4; ++m) _Pragma("unroll") for (int n = 0; n < 2; ++n) _Pragma("unroll") for (int k = 0; k < 2; ++k) \
        acc[ai][bj][m][n] = __builtin_amdgcn_mfma_f32_16x16x32_bf16(Bt[n][k], At[m][k], acc[ai][bj][m][n], 0, 0, 0); __builtin_amdgcn_s_setprio(0); } while (0)
#define PG8_WAIT_V(n) asm volatile("s_waitcnt vmcnt(" #n ")" ::: "memory")
#define PG8_WAIT_L(n) asm volatile("s_waitcnt lgkmcnt(" #n ")" ::: "memory")
#define PG8_BAR __builtin_amdgcn_s_barrier()
#define PG8_SCHED __builtin_amdgcn_sched_barrier(0)
    Unit cur, nxt; int ui = 0;
    if (!S.next(0, cur)) return;
    f32x4 acc[2][2][4][2];
#pragma unroll
    for (int a = 0; a < 2; ++a)
#pragma unroll
        for (int b = 0; b < 2; ++b)
#pragma unroll
            for (int m = 0; m < 4; ++m)
#pragma unroll
                for (int n = 0; n < 2; ++n) acc[a][b][m][n] = (f32x4){0.f, 0.f, 0.f, 0.f};
    bf16x8 At[4][2], B0[2][2], B1[2][2];
    const char* cA = g.aptr(cur); const char* cB = g.bptr(cur);
    S.a_ready(cur);
    if constexpr (SP2) {
        PG8_STAGE(PG8_SB(0, 0), cB, voffB); PG8_STAGE(PG8_SB(0, 1), cB + hstepB, voffB); PG8_STAGE(PG8_SA(0, 0), cA, voffA); PG8_STAGE(PG8_SA(0, 1), cA + hstepA, voffA);
        if (wr == 1) PG8_BAR;
        PG8_WAIT_V(2); PG8_BAR;
        PG8_STAGE(PG8_SB(1, 0), cB + kstep, voffB); PG8_STAGE(PG8_SA(1, 0), cA + kstep, voffA); PG8_STAGE(PG8_SB(1, 1), cB + hstepB + kstep, voffB);
        PG8_WAIT_V(6); PG8_BAR;
    } else {
        PG8_STAGE(PG8_SB(0, 0), cB, voffB); PG8_STAGE(PG8_SA(0, 0), cA, voffA); PG8_STAGE(PG8_SB(0, 1), cB + hstepB, voffB); PG8_STAGE(PG8_SA(0, 1), cA + hstepA, voffA);
        if (wr == 1) PG8_BAR;
        PG8_WAIT_V(4); PG8_BAR;
        PG8_STAGE(PG8_SB(1, 0), cB + kstep, voffB); PG8_STAGE(PG8_SA(1, 0), cA + kstep, voffA); PG8_STAGE(PG8_SB(1, 1), cB + hstepB + kstep, voffB);
        PG8_WAIT_V(6); PG8_BAR;
    }
    for (;;) {
        const bool has_next = S.next(ui + 1, nxt);
        const char* nA = has_next ? g.aptr(nxt) : cA; const char* nB = has_next ? g.bptr(nxt) : cB;
        for (int t = 0; t < nt; t += 2) {
            const bool last = (t == nt - 2);
            const char* a1 = cA + (size_t)(t + 1) * kstep;
            const char* a2 = last ? nA : cA + (size_t)(t + 2) * kstep; const char* b2 = last ? nB : cB + (size_t)(t + 2) * kstep;
            const char* a3 = a2 + kstep; const char* b3 = b2 + kstep;
            if (last && has_next) S.a_ready(nxt);
            if constexpr (SP2) {
            PG8_LDB(B0, 0, 0); PG8_LDB(B1, 0, 1); PG8_SCHED; PG8_LDA(At, 0, 0); PG8_STAGE(PG8_SA(1, 1), a1 + hstepA, voffA);
            PG8_WAIT_V(8); PG8_WAIT_L(0); PG8_BAR; PG8_MMA(0, 0, At, B0); PG8_MMA(0, 1, At, B1); PG8_BAR; PG8_SCHED;
            PG8_LDA(At, 0, 1); PG8_STAGE(PG8_SB(0, 0), b2, voffB); PG8_STAGE(PG8_SB(0, 1), b2 + hstepB, voffB); PG8_STAGE(PG8_SA(0, 0), a2, voffA);
            PG8_WAIT_V(8); PG8_WAIT_L(0); PG8_BAR; PG8_MMA(1, 0, At, B0); PG8_MMA(1, 1, At, B1); PG8_BAR; PG8_SCHED;
            PG8_LDB(B0, 1, 0); PG8_LDB(B1, 1, 1); PG8_SCHED; PG8_LDA(At, 1, 0); PG8_STAGE(PG8_SA(0, 1), a2 + hstepA, voffA);
            PG8_WAIT_V(8); PG8_WAIT_L(0); PG8_BAR; PG8_MMA(0, 0, At, B0); PG8_MMA(0, 1, At, B1); PG8_BAR; PG8_SCHED;
            PG8_LDA(At, 1, 1); PG8_STAGE(PG8_SB(1, 0), b3, voffB); PG8_STAGE(PG8_SB(1, 1), b3 + hstepB, voffB); PG8_STAGE(PG8_SA(1, 0), a3, voffA);
            PG8_WAIT_V(8); PG8_WAIT_L(0); PG8_BAR; PG8_MMA(1, 0, At, B0); PG8_MMA(1, 1, At, B1); PG8_BAR; PG8_SCHED;
            } else {
            PG8_LDB(B0, 0, 0); PG8_SCHED; PG8_LDA(At, 0, 0); PG8_STAGE(PG8_SA(1, 1), a1 + hstepA, voffA);
            PG8_WAIT_L(8); PG8_BAR; PG8_WAIT_L(0); PG8_MMA(0, 0, At, B0); PG8_BAR; PG8_SCHED;
            PG8_LDB(B1, 0, 1); PG8_STAGE(PG8_SB(0, 0), b2, voffB);
            PG8_BAR; PG8_WAIT_L(0); PG8_MMA(0, 1, At, B1); PG8_BAR;
            PG8_LDA(At, 0, 1); PG8_STAGE(PG8_SA(0, 0), a2, voffA);
            PG8_BAR; PG8_WAIT_L(0); PG8_MMA(1, 0, At, B0); PG8_BAR; PG8_SCHED;
            PG8_STAGE(PG8_SB(0, 1), b2 + hstepB, voffB);
            PG8_WAIT_V(6); PG8_BAR; PG8_MMA(1, 1, At, B1); PG8_BAR;
            PG8_LDB(B0, 1, 0); PG8_SCHED; PG8_LDA(At, 1, 0); PG8_STAGE(PG8_SA(0, 1), a2 + hstepA, voffA);
            PG8_WAIT_L(8); PG8_BAR; PG8_WAIT_L(0); PG8_MMA(0, 0, At, B0); PG8_BAR; PG8_SCHED;
            PG8_LDB(B1, 1, 1); PG8_STAGE(PG8_SB(1, 0), b3, voffB);
            PG8_BAR; PG8_WAIT_L(0); PG8_MMA(0, 1, At, B1); PG8_BAR;
            PG8_LDA(At, 1, 1); PG8_STAGE(PG8_SA(1, 0), a3, voffA);
            PG8_BAR; PG8_WAIT_L(0); PG8_MMA(1, 0, At, B0); PG8_BAR; PG8_SCHED;
            PG8_STAGE(PG8_SB(1, 1), b3 + hstepB, voffB);
            PG8_WAIT_V(6); PG8_BAR; PG8_MMA(1, 1, At, B1); PG8_BAR;
            }
        }
        if constexpr (ALIGN_EPI) { if (wr == 0) PG8_BAR; }
        if constexpr (!Epi::AFTER_DRAIN) { E(acc, cur, wr, wc, fr, fq); S.done(cur); }
        if (!has_next) break;
#pragma unroll
        for (int a = 0; a < 2; ++a)
#pragma unroll
            for (int b = 0; b < 2; ++b)
#pragma unroll
                for (int m = 0; m < 4; ++m)
#pragma unroll
                    for (int n = 0; n < 2; ++n) acc[a][b][m][n] = (f32x4){0.f, 0.f, 0.f, 0.f};
        cur = nxt; cA = nA; cB = nB; ++ui;
        if constexpr (ALIGN_EPI) { if (wr == 1) PG8_BAR; }
    }
    PG8_WAIT_V(0);
    if constexpr (!ALIGN_EPI) { if (wr == 0) PG8_BAR; }
    PG8_BAR;
    if constexpr (Epi::AFTER_DRAIN) { E.fused(acc, cur, wr, wc, fr, fq, lds, wid, lane); S.done(cur); }
#undef PG8_SA
#undef PG8_SB
#undef PG8_STAGE
#undef PG8_LDA
#undef PG8_LDB
#undef PG8_MMA
#undef PG8_WAIT_V
#undef PG8_WAIT_L
#undef PG8_BAR
#undef PG8_SCHED
}
}
#include <hip/hip_bf16.h>
#include <cmath>
namespace attn_body {
using bf16=__hip_bfloat16;
using bf16x8=__attribute__((ext_vector_type(8)))short;
using s16x4=__attribute__((ext_vector_type(4)))short;
using f32x16=__attribute__((ext_vector_type(16)))float;
using u32x4=__attribute__((ext_vector_type(4)))unsigned;
constexpr int SEQ=2048,D=64,DM=1024;
constexpr int NW=8,QBLK=32,QB=QBLK*NW,KVBLK=64,NQB=SEQ/QB;
constexpr int ATTN_PITCH=DM, ATTN_UNIT_ROWS=QB;
__device__ __forceinline__ int crow(int r,int hi){return (r&3)+8*(r>>2)+4*hi;}
#define SBAR() __builtin_amdgcn_sched_barrier(0)
__device__ __forceinline__ void cmask(f32x16&p0,f32x16&p1,int jb,int qrel,int hi){
  const float NEG=-INFINITY; int kb=64*jb+4*hi;
  #pragma unroll
  for(int r=0;r<16;++r){int kv=kb+(r&3)+8*(r>>2); if(kv>qrel)p0[r]=NEG; if(kv+32>qrel)p1[r]=NEG;}
}

constexpr int NSLOT=3, SLOTB=8192;
constexpr int LDS_K=0, LDS_V=NSLOT*SLOTB, LDS_WS=2*NSLOT*SLOTB, LDS_OST=LDS_WS+NW*64*4, LDS_BYTES=LDS_OST+NW*4096;
constexpr float C2=0.125f*1.4426950408889634f;
__device__ __forceinline__ void glds16(const void*gsrc,unsigned lds_dst){unsigned keep;
  asm volatile("s_mov_b32 %0, m0\n\ts_mov_b32 m0, %2\n\ts_nop 0\n\tglobal_load_lds_dwordx4 %1, off\n\ts_mov_b32 m0, %0":"=&s"(keep):"v"(gsrc),"s"(lds_dst):"memory");}
__device__ __forceinline__ float max3f(float a,float b,float c){float r;asm("v_max3_f32 %0, %1, %2, %3":"=v"(r):"v"(a),"v"(b),"v"(c));return r;}
__device__ __forceinline__ float max2f(float a,float b){float r;asm("v_max_f32_e32 %0, %1, %2":"=v"(r):"v"(a),"v"(b));return r;}
__device__ __forceinline__ float fadd_s(float a,float b){float r;asm("v_add_f32_e32 %0, %1, %2":"=v"(r):"v"(a),"v"(b));return r;}
__device__ __forceinline__ float fsub_s(float a,float b){float r;asm("v_sub_f32_e32 %0, %1, %2":"=v"(r):"v"(a),"v"(b));return r;}
typedef float f32x2_t __attribute__((ext_vector_type(2))); typedef __bf16 bf16x2_t __attribute__((ext_vector_type(2)));
__device__ __forceinline__ unsigned cvtpk_s(float lo,float hi){f32x2_t v={lo,hi};bf16x2_t b=__builtin_convertvector(v,bf16x2_t);return __builtin_bit_cast(unsigned,b);}
#define WAIT_BAR(N) asm volatile("s_waitcnt vmcnt(" #N ") lgkmcnt(0)\n\ts_barrier":::"memory")

__device__ __forceinline__ void qkt(f32x16&p0,f32x16&p1,const char*Kslot,const bf16x8*qr,const f32x16&negm,int r32,int hi){
  const char*kb=Kslot+hi*1024+r32*16;
  #pragma unroll
  for(int d0=0;d0<4;++d0){
    const bf16x8 b0=*reinterpret_cast<const bf16x8*>(kb+d0*2048);
    const bf16x8 b1=*reinterpret_cast<const bf16x8*>(kb+d0*2048+512);
    if(d0==0){p0=__builtin_amdgcn_mfma_f32_32x32x16_bf16(b0,qr[0],negm,0,0,0);p1=__builtin_amdgcn_mfma_f32_32x32x16_bf16(b1,qr[0],negm,0,0,0);}
    else{p0=__builtin_amdgcn_mfma_f32_32x32x16_bf16(b0,qr[d0],p0,0,0,0);p1=__builtin_amdgcn_mfma_f32_32x32x16_bf16(b1,qr[d0],p1,0,0,0);}}
}
typedef __attribute__((address_space(3))) const char* lds_cptr;
typedef short v4i16_t __attribute__((ext_vector_type(4)));
__device__ __forceinline__ void kload8(bf16x8*kf,lds_cptr kp){
  kf[0]=*(const __attribute__((address_space(3))) bf16x8*)(kp);      kf[1]=*(const __attribute__((address_space(3))) bf16x8*)(kp+512);
  kf[2]=*(const __attribute__((address_space(3))) bf16x8*)(kp+2048); kf[3]=*(const __attribute__((address_space(3))) bf16x8*)(kp+2560);
  kf[4]=*(const __attribute__((address_space(3))) bf16x8*)(kp+4096); kf[5]=*(const __attribute__((address_space(3))) bf16x8*)(kp+4608);
  kf[6]=*(const __attribute__((address_space(3))) bf16x8*)(kp+6144); kf[7]=*(const __attribute__((address_space(3))) bf16x8*)(kp+6656);
}
__device__ __forceinline__ void kload2(bf16x8*kf,lds_cptr kp,int j){ kf[2*j]=*(const __attribute__((address_space(3))) bf16x8*)(kp+j*2048); kf[2*j+1]=*(const __attribute__((address_space(3))) bf16x8*)(kp+j*2048+512); }
__device__ __forceinline__ s16x4 vtr(lds_cptr p){ return __builtin_bit_cast(s16x4,__builtin_amdgcn_ds_read_tr16_b64_v4i16((__attribute__((address_space(3))) v4i16_t*)p)); }
__device__ __forceinline__ float rowmax(const f32x16&p0,const f32x16&p1){
  float a=max3f(p0[0],p0[1],p1[0]),b=max3f(p0[2],p0[3],p1[1]);a=max3f(a,p1[2],p1[3]);
  #pragma unroll
  for(int r=4;r<16;r+=4){a=max3f(a,p0[r],p0[r+1]);b=max3f(b,p0[r+2],p0[r+3]);a=max3f(a,p1[r],p1[r+1]);b=max3f(b,p1[r+2],p1[r+3]);}
  const float m=max2f(a,b);
  auto rr=__builtin_amdgcn_permlane32_swap(__float_as_uint(m),__float_as_uint(m),false,false);
  return max2f(__uint_as_float(rr[0]),__uint_as_float(rr[1]));
}
__device__ __forceinline__ void pv(f32x16*o,int vb,bf16x8 pa0,bf16x8 pa1,bf16x8 pa2,bf16x8 pa3){
  #pragma unroll
  for(int d0=0;d0<2;++d0){s16x4 lo[4],hi[4];
    #pragma unroll
    for(int ks=0;ks<4;++ks){
      asm volatile("ds_read_b64_tr_b16 %0,%1 offset:%c2":"=&v"(lo[ks]):"v"(vb),"i"(d0*4096+ks*1024):"memory");
      asm volatile("ds_read_b64_tr_b16 %0,%1 offset:%c2":"=&v"(hi[ks]):"v"(vb),"i"(d0*4096+ks*1024+512):"memory");}
    asm volatile("s_waitcnt lgkmcnt(0)":::"memory");SBAR();
    #define PK(k) (bf16x8){lo[k][0],lo[k][1],lo[k][2],lo[k][3],hi[k][0],hi[k][1],hi[k][2],hi[k][3]}
    o[d0]=__builtin_amdgcn_mfma_f32_32x32x16_bf16(pa0,PK(0),o[d0],0,0,0);
    o[d0]=__builtin_amdgcn_mfma_f32_32x32x16_bf16(pa1,PK(1),o[d0],0,0,0);
    o[d0]=__builtin_amdgcn_mfma_f32_32x32x16_bf16(pa2,PK(2),o[d0],0,0,0);
    o[d0]=__builtin_amdgcn_mfma_f32_32x32x16_bf16(pa3,PK(3),o[d0],0,0,0);
    #undef PK
  }
}

#ifndef ATTN_STORE16
#define ATTN_STORE16(p,v) (*(u32x4*)(p)=(v))
#endif
template<int THRL> __device__ __forceinline__ void attn_unit(long rowbase,int qc,int kc,int vc,int oc,int qb,const bf16*Q,const bf16*__restrict__ K,const bf16*__restrict__ V,bf16*O,char*shm){
  int tid=threadIdx.x; asm volatile("":"+v"(tid)); const int lane=tid&63,r32=lane&31,hi=lane>>5; const int wid=__builtin_amdgcn_readfirstlane(tid>>6);
  const int q0=qb*QB;
  const bf16*Qw=Q+(rowbase+q0+wid*QBLK)*DM+qc;
  const bf16*Kh=K+rowbase*DM+kc,*Vh=V+rowbase*DM+vc;
  const unsigned lds0=(unsigned)(uintptr_t)shm;
  float*wsf=(float*)(shm+LDS_WS)+wid*64;
  const bf16*ksrc=Kh+(long)lane*DM+wid*8;
  const bf16*vsrc=Vh+(long)(16*(wid&3)+(lane>>2))*DM+(wid>>2)*32+(lane&3)*8;
  const unsigned kdst=lds0+LDS_K+wid*1024, vdst=lds0+LDS_V+wid*1024;
  #define DMA_K(t,slot) glds16(ksrc+(long)(t)*KVBLK*DM,(unsigned)__builtin_amdgcn_readfirstlane(kdst+(slot)))
  #define DMA_V(t,slot) glds16(vsrc+(long)(t)*KVBLK*DM,(unsigned)__builtin_amdgcn_readfirstlane(vdst+(slot)))
  const int vb0=(int)(lds0+LDS_V)+((lane>>4)&1)*32+(lane&3)*8+(4*hi+((lane&15)>>2))*64;
  const char*Kbase=shm+LDS_K; bf16x8 kf[8];
  const lds_cptr shm3=(lds_cptr)shm; const lds_cptr kp0=shm3+LDS_K+hi*1024+r32*16; const lds_cptr vp0=shm3+LDS_V+((lane>>4)&1)*32+(lane&3)*8+(4*hi+((lane&15)>>2))*64;
  const int NT=(q0+QB)/KVBLK;
  DMA_K(0,0);DMA_V(0,0);DMA_K(1,SLOTB);
  bf16x8 qr[4];
  #pragma unroll
  for(int d0=0;d0<4;++d0)qr[d0]=*reinterpret_cast<const bf16x8*>(&Qw[(long)r32*DM+d0*16+hi*8]);
  float mhat=0.f,l_reg=0.f;f32x16 o[2];o[0]=f32x16{};o[1]=f32x16{};f32x16 negm=f32x16{};asm volatile("":"+v"(negm));
  const int qrel=(wid*QBLK+r32)|63;
  #define CMASK(P0,P1,t) do{int jb_=(t)-(NT-4); if(jb_>=0)cmask(P0,P1,jb_,qrel,hi);}while(0)
  bool resc=false;
  #define START(P0,P1) do{ const float rm=rowmax(P0,P1); resc=false; \
    { const float dl=rm; mhat=fadd_s(mhat,dl); \
      _Pragma("unroll") for(int r=0;r<16;++r){P0[r]=fsub_s(P0[r],dl);P1[r]=fsub_s(P1[r],dl);} \
      _Pragma("unroll") for(int r=0;r<16;++r)negm[r]=-mhat; asm volatile("":"+v"(negm)); } \
    _Pragma("unroll") for(int r=0;r<16;++r)P0[r]=__builtin_amdgcn_exp2f(P0[r]); }while(0)
  #define RESC() do{ if(resc){ asm volatile("s_waitcnt lgkmcnt(0)":::"memory"); \
      _Pragma("unroll") for(int d_=0;d_<2;++d_) _Pragma("unroll") for(int r=0;r<16;++r)o[d_][r]*=wsf[crow(r,hi)]; } }while(0)
  f32x16 pA0,pA1,pB0,pB1;
  int sl_prev=0,sl_cur=0,sl_next=SLOTB;
  #define ROT() do{sl_prev=sl_cur;sl_cur=sl_next;sl_next=(sl_next==(NSLOT-1)*SLOTB)?0:sl_next+SLOTB;}while(0)
  DMA_K(2,2*SLOTB);
  WAIT_BAR(3);
  qkt(pA0,pA1,Kbase,qr,negm,r32,hi);asm volatile("s_nop 15\n\ts_nop 7":"+v"(pA0),"+v"(pA1));CMASK(pA0,pA1,0);
  START(pA0,pA1);
  _Pragma("unroll") for(int r=0;r<16;++r)pA1[r]=__builtin_amdgcn_exp2f(pA1[r]);
  WAIT_BAR(0);
  DMA_K(3,0);DMA_V(1,SLOTB);
  ROT();
  kload8(kf,kp0+sl_cur);
  WAIT_BAR(2);
  s16x4 vlo[8],vhi[8]; u32x4 pw0,pw1,pw2,pw3;
  #define PKW(P,B) cvtpk_s(P[B],P[B+1])
  #define PAF(k) __builtin_bit_cast(bf16x8,pw##k)
  #define VFR(i) (bf16x8){vlo[i][0],vlo[i][1],vlo[i][2],vlo[i][3],vhi[i][0],vhi[i][1],vhi[i][2],vhi[i][3]}
  #define PIN(x) asm volatile("":"+v"(x))
  #define MX3(a,b,c) __builtin_fmaxf(__builtin_fmaxf((a),(b)),(c))
  #define GAPA(MF,A0,A1,A2,A3,W0,W1,PW) do{ MF; sacc+=A0; sacc+=A1; sacc+=A2; sacc+=A3; PIN(sacc); W0; W1; PIN(PW); SBAR(); }while(0)
  #define EX(v) __builtin_amdgcn_exp2f(v)
  #define GAPB(MF,X,B) do{ MF; X[B]=EX(X[B]); X[B+1]=EX(X[B+1]); X[B+2]=EX(X[B+2]); X[B+3]=EX(X[B+3]); PIN(X); SBAR(); }while(0)
  #define VRD(i) do{ vlo[i]=vtr(vp_+(((i)>>2)*4096+((i)&3)*1024)); vhi[i]=vtr(vp_+(((i)>>2)*4096+((i)&3)*1024+512)); }while(0)
  #define KRD(G,j) do{ if(G){ kload2(kf,kp0+sl_next,j); SBAR(); } }while(0)
  #define STEP(C0,C1,P0,P1,t,GK,GV,GL) do{ SBAR(); \
    const lds_cptr vp_=vp0+sl_prev; \
    VRD(0); SBAR(); float sacc=(P0[0]+P0[1]); \
    GAPA(C0=__builtin_amdgcn_mfma_f32_32x32x16_bf16(kf[0],qr[0],negm,0,0,0), P0[2],P0[3],P0[4],P0[5],     pw0[0]=PKW(P0,0), pw0[1]=PKW(P0,2), pw0); \
    VRD(4); SBAR(); GAPA(C1=__builtin_amdgcn_mfma_f32_32x32x16_bf16(kf[1],qr[0],negm,0,0,0), P0[6],P0[7],P0[8],P0[9],     pw0[2]=PKW(P0,4), pw0[3]=PKW(P0,6), pw0); \
    VRD(1); SBAR(); GAPA(C0=__builtin_amdgcn_mfma_f32_32x32x16_bf16(kf[2],qr[1],C0,0,0,0),   P0[10],P0[11],P0[12],P0[13], pw1[0]=PKW(P0,8), pw1[1]=PKW(P0,10), pw1); \
    VRD(5); SBAR(); GAPA(C1=__builtin_amdgcn_mfma_f32_32x32x16_bf16(kf[3],qr[1],C1,0,0,0),   P0[14],P0[15],P1[0],P1[1],   pw1[2]=PKW(P0,12),pw1[3]=PKW(P0,14), pw1); \
    VRD(2); SBAR(); GAPA(C0=__builtin_amdgcn_mfma_f32_32x32x16_bf16(kf[4],qr[2],C0,0,0,0),   P1[2],P1[3],P1[4],P1[5],     pw2[0]=PKW(P1,0), pw2[1]=PKW(P1,2), pw2); \
    VRD(6); SBAR(); GAPA(C1=__builtin_amdgcn_mfma_f32_32x32x16_bf16(kf[5],qr[2],C1,0,0,0),   P1[6],P1[7],P1[8],P1[9],     pw2[2]=PKW(P1,4), pw2[3]=PKW(P1,6), pw2); \
    VRD(3); SBAR(); GAPA(C0=__builtin_amdgcn_mfma_f32_32x32x16_bf16(kf[6],qr[3],C0,0,0,0),   P1[10],P1[11],P1[12],P1[13], pw3[0]=PKW(P1,8), pw3[1]=PKW(P1,10), pw3); \
    VRD(7); SBAR(); GAPA(C1=__builtin_amdgcn_mfma_f32_32x32x16_bf16(kf[7],qr[3],C1,0,0,0),   P1[14],P1[15],0.f,0.f,       pw3[2]=PKW(P1,12),pw3[3]=PKW(P1,14), pw3); \
    l_reg+=sacc; \
    if(GK){DMA_K((t)+3,sl_cur);} if(GV){DMA_V((t)+1,sl_next);} \
    CMASK(C0,C1,t); \
    { float a=MX3(C0[0],C0[1],C1[0]),b=MX3(C0[2],C0[3],C1[1]); a=MX3(a,C1[2],C1[3]); \
      _Pragma("unroll") for(int r=4;r<16;r+=4){a=MX3(a,C0[r],C0[r+1]);b=MX3(b,C0[r+2],C0[r+3]);a=MX3(a,C1[r],C1[r+1]);b=MX3(b,C1[r+2],C1[r+3]);} \
      float rm=__builtin_fmaxf(a,b); { auto rr=__builtin_amdgcn_permlane32_swap(__float_as_uint(rm),__float_as_uint(rm),false,false); rm=__builtin_fmaxf(__uint_as_float(rr[0]),__uint_as_float(rr[1])); } \
      resc=false; \
      if(__builtin_expect(__any(rm>(float)THRL),0)){ const float dl=__builtin_fmaxf(rm,0.f); mhat+=dl; \
        _Pragma("unroll") for(int r=0;r<16;++r){C0[r]-=dl;C1[r]-=dl;} \
        _Pragma("unroll") for(int r=0;r<16;++r)negm[r]=-mhat; asm volatile("":"+v"(negm)); \
        const float f=__builtin_amdgcn_exp2f(-dl); l_reg*=f; if(hi==0)wsf[r32]=f; resc=true; } } \
    SBAR(); \
    GAPB(o[0]=__builtin_amdgcn_mfma_f32_32x32x16_bf16(PAF(0),VFR(0),o[0],0,0,0), C0,0); \
    GAPB(o[1]=__builtin_amdgcn_mfma_f32_32x32x16_bf16(PAF(0),VFR(4),o[1],0,0,0), C0,4); \
    KRD(GL,0); GAPB(o[0]=__builtin_amdgcn_mfma_f32_32x32x16_bf16(PAF(1),VFR(1),o[0],0,0,0), C0,8); \
    KRD(GL,1); GAPB(o[1]=__builtin_amdgcn_mfma_f32_32x32x16_bf16(PAF(1),VFR(5),o[1],0,0,0), C0,12); \
    KRD(GL,2); GAPB(o[0]=__builtin_amdgcn_mfma_f32_32x32x16_bf16(PAF(2),VFR(2),o[0],0,0,0), C1,0); \
    KRD(GL,3); GAPB(o[1]=__builtin_amdgcn_mfma_f32_32x32x16_bf16(PAF(2),VFR(6),o[1],0,0,0), C1,4); \
    GAPB(o[0]=__builtin_amdgcn_mfma_f32_32x32x16_bf16(PAF(3),VFR(3),o[0],0,0,0), C1,8); \
    GAPB(o[1]=__builtin_amdgcn_mfma_f32_32x32x16_bf16(PAF(3),VFR(7),o[1],0,0,0), C1,12); \
    }while(0)
  int t=1;
  #undef CMASK
  #define CMASK(P0,P1,t) do{}while(0)
  for(;t+5<NT;t+=2){
    STEP(pB0,pB1,pA0,pA1,t,true,true,true);     WAIT_BAR(2); RESC(); ROT();
    STEP(pA0,pA1,pB0,pB1,t+1,true,true,true);   WAIT_BAR(2); RESC(); ROT();
  }
  #undef CMASK
  #define CMASK(P0,P1,t) do{int jb_=(t)-(NT-4); if(jb_>=0)cmask(P0,P1,jb_,qrel,hi);}while(0)
  #define ENDW(tt) do{ if((tt)+3<NT){WAIT_BAR(2);} else if((tt)+2<NT){WAIT_BAR(1);} else {WAIT_BAR(0);} }while(0)
  for(;t+1<NT;t+=2){
    STEP(pB0,pB1,pA0,pA1,t,(t+3<NT),(t+1<NT),(t+1<NT));       ENDW(t);   RESC(); ROT();
    STEP(pA0,pA1,pB0,pB1,t+1,(t+4<NT),(t+2<NT),(t+2<NT));     ENDW(t+1); RESC(); ROT();
  }
  STEP(pB0,pB1,pA0,pA1,NT-1,false,false,false); RESC();
  { float sacc=pB0[0]+pB0[1]; _Pragma("unroll") for(int r=2;r<16;++r)sacc+=pB0[r]; _Pragma("unroll") for(int r=0;r<16;++r)sacc+=pB1[r]; l_reg+=sacc;
    pw0=(u32x4){PKW(pB0,0),PKW(pB0,2),PKW(pB0,4),PKW(pB0,6)};pw1=(u32x4){PKW(pB0,8),PKW(pB0,10),PKW(pB0,12),PKW(pB0,14)};pw2=(u32x4){PKW(pB1,0),PKW(pB1,2),PKW(pB1,4),PKW(pB1,6)};pw3=(u32x4){PKW(pB1,8),PKW(pB1,10),PKW(pB1,12),PKW(pB1,14)};
    SBAR(); pv(o,vb0+sl_cur,PAF(0),PAF(1),PAF(2),PAF(3)); }
  #undef PKW
  #undef PAF
  #undef VFR
  #undef PIN
  #undef MX3
  #undef GAPA
  #undef GAPB
  #undef EX
  #undef VRD
  #undef KRD
  #undef STEP
  #undef ENDW
  {auto rr=__builtin_amdgcn_permlane32_swap(__float_as_uint(l_reg),__float_as_uint(l_reg),false,false);l_reg=__uint_as_float(rr[0])+__uint_as_float(rr[1]);}
  if(hi==0)wsf[32+r32]=l_reg;asm volatile("s_waitcnt lgkmcnt(0)":::"memory");
  float rli[16];
  #pragma unroll
  for(int r=0;r<16;++r)rli[r]=__builtin_amdgcn_rcpf(wsf[32+crow(r,hi)]);
  bf16*Ow=O+(rowbase+q0+wid*QBLK)*DM+oc;
  { bf16*stg=(bf16*)(shm+LDS_OST)+wid*2048;
    #pragma unroll
    for(int r=0;r<16;++r){const int orow=crow(r,hi);
      #pragma unroll
      for(int d0=0;d0<2;++d0)stg[orow*64+d0*32+r32]=__float2bfloat16(o[d0][r]*rli[r]);}
    asm volatile("s_waitcnt lgkmcnt(0)":::"memory");
    #pragma unroll
    for(int i=0;i<4;++i){const int row=i*8+(lane>>3),ch=lane&7; const u32x4 v=*(const u32x4*)(stg+row*64+ch*8); ATTN_STORE16(Ow+(long)row*DM+ch*8,v);} }
  asm volatile("s_waitcnt lgkmcnt(0)\n\ts_barrier":::"memory");
  #undef DMA_K
  #undef DMA_V
  #undef CMASK
  #undef START
  #undef RESC
  #undef ROT
}
constexpr int ATTN_LDS_BYTES=LDS_BYTES;
#undef SBAR
#undef WAIT_BAR
}
#define GAS __attribute__((address_space(1)))
#define LAS __attribute__((address_space(3)))
typedef unsigned short bf16;
typedef unsigned v4u __attribute__((ext_vector_type(4)));
typedef unsigned v2u __attribute__((ext_vector_type(2)));
typedef float f32x4 __attribute__((ext_vector_type(4)));
using pg8::cvt_pk_bf16; using pg8::bf_lo; using pg8::bf_hi;

constexpr int NWAVES = 8, NTHR = 512;
constexpr int D = 1024, SEQ = 2048, NBATCH = 32, MTOK = NBATCH * SEQ, NGRP = 4, MG = MTOK / NGRP, NIN = 9216, DFF = 4096, MEMROWS = NBATCH * 256, DEPTH = 2;
constexpr float EPS = 1e-6f;
constexpr size_t MiB = 1u << 20;
constexpr size_t WS_COS = 1 * MiB, WS_SIN = WS_COS + 256 * 1024, WS_NSP = WS_SIN + 256 * 1024;
constexpr size_t WS_W = 2 * MiB, WL = 48 * MiB;
constexpr size_t W_IN = 0, W_KV = 18 * MiB, W_PA = 22 * MiB, W_PL = 24 * MiB, W_PM = 26 * MiB, W_OUT = 28 * MiB, W_UP = 30 * MiB, W_DN = 38 * MiB, W_GATE = 46 * MiB;
constexpr size_t WS_MEMN = 98 * MiB, WS_KM = 130 * MiB, WS_VT = 162 * MiB;
constexpr size_t WS_H = 194 * MiB;
constexpr size_t TB = 32 * MiB;
constexpr size_t WS_Z = 322 * MiB;
constexpr size_t WS_O1 = WS_Z + 9 * TB, WS_O2 = WS_O1 + TB, WS_XC = WS_O2 + TB, WS_LA = WS_XC + TB, WS_U = WS_LA + TB, WS_S = WS_U + TB, WS_END = WS_S + 2 * TB;
static_assert(WS_END == 834 * MiB, "ws map");
constexpr int LDS_BYTES = 147456;

__device__ __forceinline__ float wave_sum(float v) {
#pragma unroll
    for (int o = 1; o < 64; o <<= 1) v += __shfl_xor(v, o);
    return v;
}
__device__ __forceinline__ void transpose_item(const float* W, int K, int N, bf16* WT, int row_off, bool ropeperm, LAS float* scr, int item, int lane) {
    const int nblk = N / 32, kb = item / nblk, nb = item % nblk, k0 = 64 * kb, n0 = 32 * nb;
#pragma unroll 8
    for (int i = 0; i < 32; ++i) { const int kk = 2 * i + (lane >> 5); scr[kk * 33 + (lane & 31)] = W[(size_t)(k0 + kk) * N + n0 + (lane & 31)]; }
    asm volatile("s_waitcnt lgkmcnt(0)" ::: "memory");
    const int c = lane & 7;
#pragma unroll
    for (int j = 0; j < 4; ++j) { const int n = (lane >> 3) + 8 * j; const LAS float* s = scr + (8 * c) * 33 + n;
        v4u o; o.x = cvt_pk_bf16(s[0 * 33], s[1 * 33]); o.y = cvt_pk_bf16(s[2 * 33], s[3 * 33]); o.z = cvt_pk_bf16(s[4 * 33], s[5 * 33]); o.w = cvt_pk_bf16(s[6 * 33], s[7 * 33]);
        int nn = n0 + n; if (ropeperm && nn < 2048) nn = (nn & ~63) + 2 * (nn & 31) + ((nn >> 5) & 1);
        *(v4u*)(WT + (size_t)(row_off + nn) * K + k0 + 8 * c) = o; }
    asm volatile("s_waitcnt lgkmcnt(0)" ::: "memory");
}
__device__ __forceinline__ void norm_row(const float* src, const float* g, bf16* dst, int lane) {
    f32x4 v[4]; float s = 0.f;
#pragma unroll
    for (int j = 0; j < 4; ++j) { v[j] = *(const f32x4*)(src + 4 * lane + 256 * j); s += (v[j][0] * v[j][0] + v[j][1] * v[j][1]) + (v[j][2] * v[j][2] + v[j][3] * v[j][3]); }
    const float rstd = 1.0f / sqrtf(wave_sum(s) * (1.0f / D) + EPS);
#pragma unroll
    for (int j = 0; j < 4; ++j) { const f32x4 gg = *(const f32x4*)(g + 4 * lane + 256 * j); const f32x4 o = v[j] * rstd * gg;
        v2u w; w.x = cvt_pk_bf16(o[0], o[1]); w.y = cvt_pk_bf16(o[2], o[3]); *(v2u*)(dst + 4 * lane + 256 * j) = w; }
}
__device__ __forceinline__ void post_row(const float* t, const float* base, const float* gA, float* out, const float* gB, bf16* hrow, int lane) {
    f32x4 v[4]; float s = 0.f;
#pragma unroll
    for (int j = 0; j < 4; ++j) { v[j] = *(const f32x4*)(t + 4 * lane + 256 * j); s += (v[j][0] * v[j][0] + v[j][1] * v[j][1]) + (v[j][2] * v[j][2] + v[j][3] * v[j][3]); }
    const float rstd = 1.0f / sqrtf(wave_sum(s) * (1.0f / D) + EPS); float s2 = 0.f;
#pragma unroll
    for (int j = 0; j < 4; ++j) { const f32x4 gg = *(const f32x4*)(gA + 4 * lane + 256 * j), bb = *(const f32x4*)(base + 4 * lane + 256 * j);
        v[j] = bb + v[j] * rstd * gg; *(f32x4*)(out + 4 * lane + 256 * j) = v[j]; s2 += (v[j][0] * v[j][0] + v[j][1] * v[j][1]) + (v[j][2] * v[j][2] + v[j][3] * v[j][3]); }
    if (hrow) { const float rstd2 = 1.0f / sqrtf(wave_sum(s2) * (1.0f / D) + EPS);
#pragma unroll
        for (int j = 0; j < 4; ++j) { const f32x4 gg = *(const f32x4*)(gB + 4 * lane + 256 * j); const f32x4 o = v[j] * rstd2 * gg;
            v2u w; w.x = cvt_pk_bf16(o[0], o[1]); w.y = cvt_pk_bf16(o[2], o[3]); *(v2u*)(hrow + 4 * lane + 256 * j) = w; } }
}
__device__ __forceinline__ void combine_row(const bf16* o1, const bf16* o2, const float* subln, float lam, float omli, bf16* y, int lane) {
    const v4u a0 = *(const v4u*)(o1 + 16 * lane), a1 = *(const v4u*)(o1 + 16 * lane + 8), b0 = *(const v4u*)(o2 + 16 * lane), b1 = *(const v4u*)(o2 + 16 * lane + 8);
    float d[16]; const unsigned aw[8] = {a0.x, a0.y, a0.z, a0.w, a1.x, a1.y, a1.z, a1.w}, bw[8] = {b0.x, b0.y, b0.z, b0.w, b1.x, b1.y, b1.z, b1.w};
    float s = 0.f;
#pragma unroll
    for (int i = 0; i < 8; ++i) { d[2 * i] = bf_lo(aw[i]) - lam * bf_lo(bw[i]); d[2 * i + 1] = bf_hi(aw[i]) - lam * bf_hi(bw[i]); s += d[2 * i] * d[2 * i] + d[2 * i + 1] * d[2 * i + 1]; }
    s += __shfl_xor(s, 1); s += __shfl_xor(s, 2); s += __shfl_xor(s, 4);
    const float rstd = omli / sqrtf(s * (1.0f / 128.0f) + EPS); const float* gp = subln + 16 * (lane & 7);
    unsigned w[8];
#pragma unroll
    for (int i = 0; i < 8; ++i) w[i] = cvt_pk_bf16(d[2 * i] * rstd * gp[2 * i], d[2 * i + 1] * rstd * gp[2 * i + 1]);
    *(v4u*)(y + 16 * lane) = (v4u){w[0], w[1], w[2], w[3]}; *(v4u*)(y + 16 * lane + 8) = (v4u){w[4], w[5], w[6], w[7]};
}
__device__ __forceinline__ void softmax_row(const float* srow, bf16* prow, int lane) {
    f32x4 v[4]; float mx = -3.0e38f;
#pragma unroll
    for (int j = 0; j < 4; ++j) { v[j] = *(const f32x4*)(srow + 16 * lane + 4 * j); mx = fmaxf(fmaxf(fmaxf(v[j][0], v[j][1]), fmaxf(v[j][2], v[j][3])), mx); }
    mx = fmaxf(mx, __shfl_xor(mx, 1)); mx = fmaxf(mx, __shfl_xor(mx, 2)); mx = fmaxf(mx, __shfl_xor(mx, 4)); mx = fmaxf(mx, __shfl_xor(mx, 8));
    float s = 0.f;
#pragma unroll
    for (int j = 0; j < 4; ++j) {
#pragma unroll
        for (int i = 0; i < 4; ++i) { v[j][i] = __expf(v[j][i] - mx); s += v[j][i]; } }
    s += __shfl_xor(s, 1); s += __shfl_xor(s, 2); s += __shfl_xor(s, 4); s += __shfl_xor(s, 8);
    const float inv = 1.0f / s;
    v4u w0, w1; w0.x = cvt_pk_bf16(v[0][0] * inv, v[0][1] * inv); w0.y = cvt_pk_bf16(v[0][2] * inv, v[0][3] * inv); w0.z = cvt_pk_bf16(v[1][0] * inv, v[1][1] * inv); w0.w = cvt_pk_bf16(v[1][2] * inv, v[1][3] * inv);
    w1.x = cvt_pk_bf16(v[2][0] * inv, v[2][1] * inv); w1.y = cvt_pk_bf16(v[2][2] * inv, v[2][3] * inv); w1.z = cvt_pk_bf16(v[3][0] * inv, v[3][1] * inv); w1.w = cvt_pk_bf16(v[3][2] * inv, v[3][3] * inv);
    *(v4u*)(prow + 16 * lane) = w0; *(v4u*)(prow + 16 * lane + 8) = w1;
}
__device__ __forceinline__ float ld_bf(const bf16* p) { return __uint_as_float((unsigned)(*p) << 16); }
__device__ __forceinline__ bf16 st_bf(float f) { return (bf16)(cvt_pk_bf16(f, 0.f) & 0xffffu); }

typedef GAS unsigned gu32;
#define RLX_AGENT __ATOMIC_RELAXED, __HIP_MEMORY_SCOPE_AGENT
#define XB_TMO      128
#define XB_XCNT(j)  (256  + 64 * (j))
#define XB_XSUB(j)  (1280 + 64 * (j))
#define XB_XGEN(j)  (2304 + 64 * (j))
#define XB_TOP      3328
#define XB_TOPGEN   3392
#define XCD_BAR_WORDS 3456
#define XB_SPIN_CAP (1u << 24)

__device__ __forceinline__ unsigned xb_ld(unsigned* p)              { return __hip_atomic_load(p, __ATOMIC_RELAXED, __HIP_MEMORY_SCOPE_AGENT); }
__device__ __forceinline__ unsigned xb_add(unsigned* p, unsigned v) { return __hip_atomic_fetch_add(p, v, __ATOMIC_RELAXED, __HIP_MEMORY_SCOPE_AGENT); }
__device__ __forceinline__ unsigned xb_xcc_id() { return (unsigned)__builtin_amdgcn_s_getreg((3 << 11) | 20) & 0xFu; }
#define XB_SPIN(cond, bar) do { unsigned _sp = 0; while (cond) { __builtin_amdgcn_s_sleep(1); \
    if ((++_sp & 255u) == 0u) { if (xb_ld(&(bar)[XB_TMO])) break; if (_sp > XB_SPIN_CAP) { atomicAdd(&(bar)[XB_TMO], 1u); break; } } } } while (0)

struct XcdBarrier {
    unsigned* bar; unsigned x;
    volatile LAS unsigned* st;
};

__device__ __forceinline__ XcdBarrier xcd_barrier_post(unsigned* bar, volatile LAS unsigned* st) {
    XcdBarrier b; b.bar = bar; b.x = xb_xcc_id(); b.st = st;
    if (threadIdx.x == 0) (void)xb_add(&bar[XB_XCNT(b.x)], 1u);
    return b;
}
__device__ __forceinline__ void xcd_barrier_complete(unsigned* bar, unsigned x, unsigned& nloc, unsigned& nx) {
    const unsigned G = gridDim.x * gridDim.y * gridDim.z;
    unsigned sum, cnt, mine, sp = 0u;
    for (;;) {
        sum = 0u; cnt = 0u; mine = 0u;
#pragma unroll
        for (unsigned j = 0; j < 16; ++j) { const unsigned c = xb_ld(&bar[XB_XCNT(j)]); sum += c; cnt += (c > 0u) ? 1u : 0u; mine = (j == x) ? c : mine; }
        if (sum == G) break;
        __builtin_amdgcn_s_sleep(1);
        if ((++sp & 255u) == 0u) { if (xb_ld(&bar[XB_TMO])) break; if (sp > XB_SPIN_CAP) { atomicAdd(&bar[XB_TMO], 1u); break; } }
    }
    nloc = mine > 0u ? mine : 1u; nx = cnt > 0u ? cnt : 1u;
}

__device__ __forceinline__ void xcd_barrier(const XcdBarrier& b) {
    asm volatile("s_waitcnt vmcnt(0)" ::: "memory");
    __syncthreads();
    if (threadIdx.x == 0) {
        unsigned* bar = b.bar;
        __builtin_amdgcn_s_waitcnt(0);
        unsigned nloc = b.st[0], nx = b.st[1];
        if (nloc == 0u) { xcd_barrier_complete(bar, b.x, nloc, nx); b.st[0] = nloc; b.st[1] = nx; }
        const unsigned old = xb_add(&bar[XB_XSUB(b.x)], 1u);
        const unsigned gen = old / nloc;
        if (old + 1u == (gen + 1u) * nloc) {
            __builtin_amdgcn_fence(__ATOMIC_RELEASE, "agent");
            asm volatile("s_waitcnt vmcnt(0)" ::: "memory");
            const unsigned og = xb_add(&bar[XB_TOP], 1u);
            const unsigned tg = og / nx;
            if (og + 1u == (tg + 1u) * nx) xb_add(&bar[XB_TOPGEN], 1u);
            else XB_SPIN(xb_ld(&bar[XB_TOPGEN]) == tg, bar);
            __builtin_amdgcn_fence(__ATOMIC_ACQUIRE, "agent");
            xb_add(&bar[XB_XGEN(b.x)], 1u);
            asm volatile("s_waitcnt vmcnt(0)" ::: "memory");
        } else {
            XB_SPIN(xb_ld(&bar[XB_XGEN(b.x)]) == gen, bar);
            __builtin_amdgcn_fence(__ATOMIC_ACQUIRE, "agent");
            asm volatile("s_waitcnt vmcnt(0)" ::: "memory");
        }
    }
    __syncthreads();
}

struct Args { const float* in[28]; float* out; unsigned char* ws; int ph_lo, ph_hi; };

__global__ void __launch_bounds__(NTHR, 2) hybrid_fwd(Args args) {
    extern __shared__ __attribute__((aligned(16))) unsigned char lds[];
    cg::grid_group grid = cg::this_grid();
    LAS unsigned char* ldsl = (LAS unsigned char*)lds;
    const int G = gridDim.x, bx = blockIdx.x, vcu = (G % 8 == 0) ? (bx % 8) * (G / 8) + bx / 8 : bx;
    const int NGW = G * NWAVES;
#define PHASE_IDS() long oz_ = 0; asm volatile("" : "+s"(oz_)); unsigned char* ws = args.ws + oz_;     int tid = threadIdx.x; asm volatile("" : "+v"(tid)); const int lane = tid & 63, wave = __builtin_amdgcn_readfirstlane(tid >> 6), gw = vcu * NWAVES + wave; (void)lane; (void)gw
    const float* x_in = args.in[0]; float* out = args.out;
#define cosT ((const float*)(ws + WS_COS))
#define sinT ((const float*)(ws + WS_SIN))
#define nspT ((float*)(ws + WS_NSP))
#define Hb ((bf16*)(ws + WS_H))
#define Z ((bf16*)(ws + WS_Z))
    constexpr long SECSZ = (long)MG * 1024;
#define ZQ Z
#define ZK (Z + SECSZ)
#define ZV (Z + 2 * SECSZ)
#define ZX (Z + 3 * SECSZ)
#define GZY (Z + 4 * SECSZ)
#define ZXQ (Z + 5 * SECSZ)
#define GATES (Z + 6 * SECSZ)
#define O1 ((bf16*)(ws + WS_O1))
#define O2 ((bf16*)(ws + WS_O2))
#define XC ((bf16*)(ws + WS_XC))
#define LA ((bf16*)(ws + WS_LA))
#define UU ((bf16*)(ws + WS_U))
#define Sf ((float*)(ws + WS_S))
#define YA ZQ
#define YL ZX
#define YM ZXQ
#define Pb ZV
#define MB ZK
#define HID ZQ
#define MF ((float*)(ws + WS_O1))
#define Tf Sf
#define wl (ws + WS_W + (size_t)l * WL)
    const int lo = args.ph_lo, hi = args.ph_hi; int ph = 0;
    { volatile LAS unsigned* MISC0 = (volatile LAS unsigned*)(ldsl + 131072 + 320); if (threadIdx.x < 32) MISC0[threadIdx.x] = 0u; __syncthreads(); }
    const XcdBarrier xbar = xcd_barrier_post((unsigned*)(args.ws) + 4096, (volatile LAS unsigned*)(ldsl + 131072 + 320) + 8);
#ifndef PHMASK
#define PHMASK 0xffffffffu
#endif
#define IN_PH() (lo <= ph && ph < hi)
#define SEAM_CG() do { if (lo <= ph && ph + 1 < hi) grid.sync(); ++ph; } while (0)
#define SEAM() do { if (lo <= ph && ph + 1 < hi) xcd_barrier(xbar); ++ph; } while (0)
#define WG_SYNC() __syncthreads()

    if (IN_PH() && ((PHMASK >> 0) & 1)) {
                PHASE_IDS();
        LAS float* scr = (LAS float*)(ldsl + wave * 16384);
        constexpr int I_IN = 16 * (NIN / 32), I_KV = 16 * 64, I_SQ = 16 * 32, I_UP = 16 * 128, I_DN = 64 * 32, I_G = 8, I_L = I_IN + I_KV + 4 * I_SQ + I_UP + I_DN + 16 * I_G;
        for (int it = gw; it < DEPTH * I_L; it += NGW) {
            const int l = it / I_L; int r = it % I_L;
            if (r < I_IN) { transpose_item(args.in[7] + (size_t)l * D * NIN, D, NIN, (bf16*)(wl + W_IN), 0, true, scr, r, lane); continue; } r -= I_IN;
            if (r < I_KV) { transpose_item(args.in[21] + (size_t)l * D * 2048, D, 2048, (bf16*)(wl + W_KV), 0, false, scr, r, lane); continue; } r -= I_KV;
            if (r < I_SQ) { transpose_item(args.in[22] + (size_t)l * D * D, D, D, (bf16*)(wl + W_PA), 0, false, scr, r, lane); continue; } r -= I_SQ;
            if (r < I_SQ) { transpose_item(args.in[23] + (size_t)l * D * D, D, D, (bf16*)(wl + W_PL), 0, false, scr, r, lane); continue; } r -= I_SQ;
            if (r < I_SQ) { transpose_item(args.in[24] + (size_t)l * D * D, D, D, (bf16*)(wl + W_PM), 0, false, scr, r, lane); continue; } r -= I_SQ;
            if (r < I_SQ) { transpose_item(args.in[25] + (size_t)l * D * D, D, D, (bf16*)(wl + W_OUT), 0, false, scr, r, lane); continue; } r -= I_SQ;
            if (r < I_UP) { transpose_item(args.in[26] + (size_t)l * D * DFF, D, DFF, (bf16*)(wl + W_UP), 0, false, scr, r, lane); continue; } r -= I_UP;
            if (r < I_DN) { transpose_item(args.in[27] + (size_t)l * DFF * D, DFF, D, (bf16*)(wl + W_DN), 0, false, scr, r, lane); continue; } r -= I_DN;
            { const int mat = r / I_G, n = mat >> 1, which = mat & 1;
              transpose_item(args.in[which ? 18 : 16] + (size_t)l * 8 * 128 * 128 + (size_t)n * 128 * 128, 128, 128, (bf16*)(wl + W_GATE), n * 256 + which * 128, false, scr, r % I_G, lane); }
        }
        for (int i = bx * NTHR + tid; i < SEQ * 32; i += G * NTHR) {
            const int pos = i >> 5, dd = i & 31; const float inv = 1.0f / exp2f((float)dd * (13.287712379549449f / 32.0f)); const float ang = (float)pos * inv;
            const double a = (double)ang, rr = a - 6.283185307179586 * __builtin_rint(a * 0.15915494309189535); const float rf = (float)rr;
            ((float*)(ws + WS_COS))[i] = __cosf(rf); ((float*)(ws + WS_SIN))[i] = __sinf(rf);
        }
        for (int i = bx * NTHR + tid; i < DEPTH * D; i += G * NTHR) nspT[i] = -8.0f * log1pf(__expf(-args.in[20][i]));
        for (int m = gw; m < DEPTH * MEMROWS; m += NGW) { const int l = m / MEMROWS, r = m % MEMROWS; norm_row(args.in[1] + (size_t)r * D, args.in[6] + l * D, (bf16*)(ws + WS_MEMN + (size_t)l * 16 * MiB) + (size_t)r * D, lane); }
        for (int m = gw; m < MTOK; m += NGW) norm_row(x_in + (size_t)m * D, args.in[2], Hb + (size_t)m * D, lane);
    }
    SEAM_CG();
    if (IN_PH() && ((PHMASK >> 1) & 1)) {
                PHASE_IDS();
#pragma unroll 1
        for (int l = 0; l < DEPTH; ++l) {
            const bf16* wkv = (const bf16*)(ws + WS_W + (size_t)l * WL + W_KV); const bf16* memn = (const bf16*)(ws + WS_MEMN + (size_t)l * 16 * MiB);
            { pg8::GemmB g = pg8::gemm_plain(memn, D, wkv, D, D); pg8::StaticOrder S; S.init(MEMROWS, 1024, G, bx); pg8::EpiPlain E{(bf16*)(ws + WS_KM + (size_t)l * 16 * MiB), 1024, 0, 1.0f};
              pg8::gemm_phase<pg8::EpiPlain, pg8::GemmB, pg8::StaticOrder>(ldsl, g, S, E); }
            { pg8::GemmB g = pg8::gemm_plain(wkv + (size_t)1024 * D, D, memn, D, D); pg8::StaticOrder S; S.init(1024, MEMROWS, G, bx); pg8::EpiPlain E{(bf16*)(ws + WS_VT + (size_t)l * 16 * MiB), MEMROWS, 0, 1.0f};
              pg8::gemm_phase<pg8::EpiPlain, pg8::GemmB, pg8::StaticOrder>(ldsl, g, S, E); }
        }
    }
    SEAM();
#pragma unroll 1
    for (int l = 0; l < DEPTH; ++l) {
        const float lam_init = l == 0 ? 0.2f : 0.35550906759096924f;
#pragma unroll 1
        for (int grp = 0; grp < NGRP; ++grp) {
            const size_t grow = (size_t)grp * MG;
            if (IN_PH() && ((PHMASK >> 2) & 1)) {
                PHASE_IDS();
                pg8::GemmB g = pg8::gemm_plain(Hb + grow * D, D, (const bf16*)(wl + W_IN), D, D); pg8::StaticOrder S; S.init(MG, NIN, G, bx);
                pg8::EpiInProj E{Z, SECSZ, cosT, sinT, args.in[8] + l * 3 * D, 0.125f * 1.4426950408889634f};
                pg8::gemm_phase<pg8::EpiInProj, pg8::GemmB, pg8::StaticOrder>(ldsl, g, S, E);
            }
            SEAM();
            if (IN_PH() && ((PHMASK >> 3) & 1)) {
                PHASE_IDS();
#ifndef NO_ATTN
                for (int unit = vcu; unit < 256; unit += G) {
                    const int b = unit >> 5, vh = unit & 31, h = vh >> 2, j = (vh >> 1) & 1, e = vh & 1;
#pragma unroll 1
                    for (int qb = 7; qb >= 0; --qb)
                        attn_body::attn_unit<8>((long)b * SEQ, h * 128 + j * 64, h * 128 + j * 64, h * 128 + e * 64, h * 128 + e * 64, qb,
                                                (const attn_body::bf16*)ZQ, (const attn_body::bf16*)ZK, (const attn_body::bf16*)ZV, (attn_body::bf16*)(j ? O2 : O1), (char*)lds);
                }
#endif
                WG_SYNC();
                { const float* cw = args.in[14] + l * 4 * D; const float* cb = args.in[15] + l * D;
                  for (int idx = bx * NTHR + tid; idx < MG * 128; idx += G * NTHR) {
                      const int row = idx >> 7, ch = (idx & 127) * 8, pos = row & (SEQ - 1);
                      float a[8];
#pragma unroll
                      for (int i = 0; i < 8; ++i) a[i] = cb[ch + i];
#pragma unroll
                      for (int k = 0; k < 4; ++k) if (pos - 3 + k >= 0) {
                          const v4u xw = *(const v4u*)(ZX + (size_t)(row - 3 + k) * D + ch); const f32x4 w0 = *(const f32x4*)(cw + k * D + ch), w1 = *(const f32x4*)(cw + k * D + ch + 4);
                          a[0] += bf_lo(xw.x) * w0[0]; a[1] += bf_hi(xw.x) * w0[1]; a[2] += bf_lo(xw.y) * w0[2]; a[3] += bf_hi(xw.y) * w0[3];
                          a[4] += bf_lo(xw.z) * w1[0]; a[5] += bf_hi(xw.z) * w1[1]; a[6] += bf_lo(xw.w) * w1[2]; a[7] += bf_hi(xw.w) * w1[3]; }
                      v4u o; o.x = cvt_pk_bf16(a[0], a[1]); o.y = cvt_pk_bf16(a[2], a[3]); o.z = cvt_pk_bf16(a[4], a[5]); o.w = cvt_pk_bf16(a[6], a[7]);
                      *(v4u*)(XC + (size_t)row * D + ch) = o; } }
                WG_SYNC();
                { pg8::GemmB g; g.A = ZXQ; g.B = (const bf16*)(ws + WS_KM + (size_t)l * 16 * MiB) + (size_t)grp * 8 * 256 * 1024; g.K = 256; g.lda = 1024; g.ldb = 1024; g.b_div = 8;
                  g.a_pm = 256L * 1024; g.a_pn = 256; g.b_bs = 256L * 1024; g.b_pn = 256;
                  pg8::StaticOrder S; S.init(MG, 1024, G, bx); pg8::EpiF32 E{Sf, 1024};
                  pg8::gemm_phase<pg8::EpiF32, pg8::GemmB, pg8::StaticOrder>(ldsl, g, S, E); }
            }
            SEAM();
            if (IN_PH() && ((PHMASK >> 4) & 1)) {
                PHASE_IDS();
                float lam;
                { const float p1 = args.in[9][l * 64 + lane] * args.in[10][l * 64 + lane], p2 = args.in[11][l * 64 + lane] * args.in[12][l * 64 + lane];
                  lam = __expf(wave_sum(p1)) - __expf(wave_sum(p2)) + lam_init; }
                const float* subln = args.in[13] + l * 128;
                for (int m = gw; m < MG; m += NGW) { combine_row(O1 + (size_t)m * D, O2 + (size_t)m * D, subln, lam, 1.0f - lam_init, YA + (size_t)m * D, lane);
                                                     softmax_row(Sf + (size_t)m * D, Pb + (size_t)m * D, lane); }
                WG_SYNC();
                { pg8::GemmB g; g.A = XC; g.B = (const bf16*)(wl + W_GATE); g.K = 128; g.lda = 1024; g.ldb = 128; g.b_div = 1; g.a_pm = 256L * 1024; g.a_pn = 128; g.b_bs = 0; g.b_pn = 256L * 128;
                  pg8::StaticOrder S; S.init(MG, 2048, G, bx); pg8::EpiGate E{XC, LA, UU, args.in[17] + l * D, args.in[19] + l * D, nspT + l * D};
                  pg8::gemm_phase<pg8::EpiGate, pg8::GemmB, pg8::StaticOrder>(ldsl, g, S, E); }
            }
            SEAM();
            if (IN_PH() && ((PHMASK >> 5) & 1)) {
                PHASE_IDS();
                LAS float* sA = (LAS float*)ldsl; LAS float* sH = sA + 512;
                for (int unit = vcu; unit < 256; unit += G) {
                    const int b = unit >> 5, cb = unit & 31, ch = tid & 31, chunk = tid >> 5;
                    const size_t i0 = ((size_t)b * SEQ + (size_t)chunk * 128) * D + cb * 32 + ch;
                    float Asum = 0.f, hh = 0.f;
#pragma unroll 8
                    for (int t = 0; t < 128; ++t) { const float lv = ld_bf(LA + i0 + (size_t)t * D), uv = ld_bf(UU + i0 + (size_t)t * D); hh = __expf(lv) * hh + uv; Asum += lv; }
                    sA[tid] = Asum; sH[tid] = hh;
                    WG_SYNC();
                    float c = 0.f;
                    for (int k = 0; k < chunk; ++k) c = __expf(sA[k * 32 + ch]) * c + sH[k * 32 + ch];
                    hh = c;
#pragma unroll 8
                    for (int t = 0; t < 128; ++t) { const size_t ii = i0 + (size_t)t * D; const float lv = ld_bf(LA + ii), uv = ld_bf(UU + ii); hh = __expf(lv) * hh + uv; YL[ii] = st_bf(hh * ld_bf(GZY + ii)); }
                    WG_SYNC();
                }
                { pg8::GemmB g; g.A = Pb; g.B = (const bf16*)(ws + WS_VT + (size_t)l * 16 * MiB) + (size_t)grp * 8 * 256; g.K = 256; g.lda = 1024; g.ldb = MEMROWS; g.b_div = 8;
                  g.a_pm = 256L * 1024; g.a_pn = 256; g.b_bs = 256; g.b_pn = 256L * MEMROWS;
                  pg8::StaticOrder S; S.init(MG, 1024, G, bx); pg8::EpiPlain E{YM, 1024, 0, 1.0f};
                  pg8::gemm_phase<pg8::EpiPlain, pg8::GemmB, pg8::StaticOrder>(ldsl, g, S, E); }
            }
            SEAM();
            if (IN_PH() && ((PHMASK >> 6) & 1)) {
                PHASE_IDS();
                pg8::StaticOrder S; S.init(MG, 1024, G, bx);
                { pg8::GemmB g = pg8::gemm_plain(YA, D, (const bf16*)(wl + W_PA), D, D); pg8::EpiMerge<0> E{GATES, MF, MB}; pg8::gemm_phase<pg8::EpiMerge<0>, pg8::GemmB, pg8::StaticOrder>(ldsl, g, S, E); }
                { pg8::GemmB g = pg8::gemm_plain(YL, D, (const bf16*)(wl + W_PL), D, D); pg8::EpiMerge<1> E{GATES + SECSZ, MF, MB}; pg8::gemm_phase<pg8::EpiMerge<1>, pg8::GemmB, pg8::StaticOrder>(ldsl, g, S, E); }
                { pg8::GemmB g = pg8::gemm_plain(YM, D, (const bf16*)(wl + W_PM), D, D); pg8::EpiMerge<2> E{GATES + 2 * SECSZ, MF, MB}; pg8::gemm_phase<pg8::EpiMerge<2>, pg8::GemmB, pg8::StaticOrder>(ldsl, g, S, E); }
            }
            SEAM();
            if (IN_PH() && ((PHMASK >> 7) & 1)) {
                PHASE_IDS();
                pg8::GemmB g = pg8::gemm_plain(MB, D, (const bf16*)(wl + W_OUT), D, D); pg8::StaticOrder S; S.init(MG, 1024, G, bx); pg8::EpiF32 E{Tf, 1024};
                pg8::gemm_phase<pg8::EpiF32, pg8::GemmB, pg8::StaticOrder>(ldsl, g, S, E);
            }
            SEAM();
            if (IN_PH() && ((PHMASK >> 8) & 1)) {
                PHASE_IDS();
                const float* base = (l == 0 ? x_in : out) + grow * D;
                for (int m = gw; m < MG; m += NGW) post_row(Tf + (size_t)m * D, base + (size_t)m * D, args.in[3] + l * D, out + (grow + m) * D, args.in[4] + l * D, Hb + (grow + m) * D, lane);
            }
            SEAM();
            if (IN_PH() && ((PHMASK >> 9) & 1)) {
                PHASE_IDS();
                pg8::GemmB g = pg8::gemm_plain(Hb + grow * D, D, (const bf16*)(wl + W_UP), D, D); pg8::StaticOrder S; S.init(MG, DFF, G, bx); pg8::EpiPlain E{HID, DFF, 1, 1.0f};
                pg8::gemm_phase<pg8::EpiPlain, pg8::GemmB, pg8::StaticOrder>(ldsl, g, S, E);
            }
            SEAM();
            if (IN_PH() && ((PHMASK >> 10) & 1)) {
                PHASE_IDS();
                pg8::GemmB g = pg8::gemm_plain(HID, DFF, (const bf16*)(wl + W_DN), DFF, DFF); pg8::StaticOrder S; S.init(MG, 1024, G, bx); pg8::EpiF32 E{Tf, 1024};
                pg8::gemm_phase<pg8::EpiF32, pg8::GemmB, pg8::StaticOrder>(ldsl, g, S, E);
            }
            SEAM();
            if (IN_PH() && ((PHMASK >> 11) & 1)) {
                PHASE_IDS();
                const bool more = (l + 1 < DEPTH);
                for (int m = gw; m < MG; m += NGW) post_row(Tf + (size_t)m * D, out + (grow + m) * D, args.in[5] + l * D, out + (grow + m) * D, more ? args.in[2] + (l + 1) * D : nullptr, more ? Hb + (grow + m) * D : nullptr, lane);
            }
            SEAM();
#ifdef DUMP_AT
            if (ph > DUMP_AT) break;
#endif
        }
#ifdef DUMP_AT
        if (ph > DUMP_AT) break;
#endif
    }
#ifdef DUMP_AT
    {
        xcd_barrier(xbar);
        unsigned char* ws = args.ws;
        const bf16* src[4] = {DUMP_B0, DUMP_B1, DUMP_B2, DUMP_B3};
        for (long i = (long)blockIdx.x * NTHR + threadIdx.x; i < 4L * MG * 1024; i += (long)G * NTHR) { const int q = (int)(i / ((long)MG * 1024)); const long r = i % ((long)MG * 1024);
            const bf16* p = q == 0 ? src[0] : q == 1 ? src[1] : q == 2 ? src[2] : src[3]; out[i] = ld_bf(p + r); }
    }
#endif
}

extern "C" void kernel_launch(void* const* d_in, const int* in_sizes, int n_in, void* d_out, int out_size, void* d_ws, size_t ws_size, hipStream_t stream) {
    static int grid = 0;
    if (grid == 0) {
        if (n_in != 28 || out_size != MTOK * D || ws_size < WS_END) { fprintf(stderr, "kernel_launch: unexpected shapes: n_in %d out %d ws %zu (need %zu)\n", n_in, out_size, ws_size, (size_t)WS_END); grid = -1; return; }
        int dev = 0, cus = 0, per_cu = 0;
        if (hipGetDevice(&dev) != hipSuccess || hipDeviceGetAttribute(&cus, hipDeviceAttributeMultiprocessorCount, dev) != hipSuccess) { grid = -1; return; }
        if (hipFuncSetAttribute((const void*)hybrid_fwd, hipFuncAttributeMaxDynamicSharedMemorySize, LDS_BYTES) != hipSuccess) { fprintf(stderr, "kernel_launch: hipFuncSetAttribute failed\n"); grid = -1; return; }
        if (hipOccupancyMaxActiveBlocksPerMultiprocessor(&per_cu, (const void*)hybrid_fwd, NTHR, LDS_BYTES) != hipSuccess || per_cu < 1) { fprintf(stderr, "kernel_launch: occupancy query says %d\n", per_cu); }
        (void)hipGetLastError();
        grid = cus;
    }
    if (grid < 0) return;
    if (hipMemsetAsync(d_ws, 0, 1u << 20, stream) != hipSuccess) { fprintf(stderr, "kernel_launch: memset failed\n"); return; }
    Args a{};
    for (int i = 0; i < 28; ++i) a.in[i] = (const float*)d_in[i];
    a.out = (float*)d_out; a.ws = (unsigned char*)d_ws; a.ph_lo = 0; a.ph_hi = 1 << 20;
#ifdef DUMP_AT
    a.ph_hi = DUMP_AT + 1;
#endif
    void* kargs[] = {&a};
    hipError_t e = hipLaunchCooperativeKernel((const void*)hybrid_fwd, dim3(grid), dim3(NTHR), kargs, LDS_BYTES, stream);
    if (e != hipSuccess) fprintf(stderr, "kernel_launch: cooperative launch failed: %s (grid %d)\n", hipGetErrorString(e), grid);
}
```

```cpp
#include <hip/hip_runtime.h>
#include <hip/hip_cooperative_groups.h>
#include <cstdio>
#include <cstdint>
namespace cg = cooperative_groups;
namespace pg8 {
#define PG8_LAS __attribute__((address_space(3)))
typedef unsigned short bf16_t;
typedef short bf16x8 __attribute__((ext_vector_type(8)));
typedef float f32x4 __attribute__((ext_vector_type(4)));
typedef unsigned u32x4 __attribute__((ext_vector_type(4)));
constexpr int BM = 256, BK = 64, HALF = 128, HTB = HALF * BK * 2  , STAGE_BYTES = 8 * HTB, NXCD = 8, WGM = 8;

__host__ __device__ __forceinline__ int lds_byte(int r, int c) { const int st = (r >> 4) * 2 + (c >> 5), rr = r & 15, cc = c & 31, ob = rr * 64 + cc * 2; return st * 1024 + (ob ^ (((ob >> 9) & 1) << 5)); }
__host__ __device__ __forceinline__ void stage_rc(int b, int& R, int& C) { const int st = b / 1024, sb = b % 1024, swz = sb ^ (((sb >> 9) & 1) << 5); R = (st >> 1) * 16 + swz / 64; C = (st & 1) * 32 + (swz % 64) / 2; }
__host__ __device__ __forceinline__ int perm32(int rho) { const int n = rho >> 4, i = rho & 15; return 8 * (i >> 2) + 4 * n + (i & 3); }

struct Unit { int pm, pn; };
struct Gemm { const bf16_t* A; const bf16_t* Bt; int M, N, K; };

struct StaticOrder {
    int nM, nN, nwg, G, c;
    __host__ __device__ void init(int M, int N, int G_, int c_) { nM = M / BM; nN = N / BM; nwg = nM * nN; G = G_; c = c_; }
    __host__ __device__ bool next(int i, Unit& u) const {
        const long L = (long)i * G + c; if (L >= nwg) return false;
        int wgid = (int)L; { const int q = nwg / NXCD, r = nwg % NXCD, xcd = wgid % NXCD, off = wgid / NXCD; wgid = (xcd < r ? xcd * (q + 1) : r * (q + 1) + (xcd - r) * q) + off; }
        const int nig = WGM * nN, gid = wgid / nig, fm = gid * WGM, gsz = (nM - fm) < WGM ? (nM - fm) : WGM;
        u.pm = fm + ((wgid % nig) % gsz); u.pn = (wgid % nig) / gsz; return true;
    }
    __device__ __forceinline__ void a_ready(const Unit&) const {}
    __device__ __forceinline__ void done(const Unit&) const {}
};

typedef float f32x2c_t __attribute__((ext_vector_type(2))); typedef __bf16 bf16x2c_t __attribute__((ext_vector_type(2)));
__device__ __forceinline__ unsigned cvt_pk_bf16(float lo, float hi) { f32x2c_t v = {lo, hi}; bf16x2c_t b = __builtin_convertvector(v, bf16x2c_t); return __builtin_bit_cast(unsigned, b); }
typedef float f32x2 __attribute__((ext_vector_type(2)));
struct GemmB {
    const bf16_t* A; const bf16_t* B; int K, lda, ldb, b_div; long a_pm, a_pn, b_bs, b_pn;
    __device__ __forceinline__ const char* aptr(const Unit& u) const { return (const char*)(A + (long)u.pm * a_pm + (long)u.pn * a_pn); }
    __device__ __forceinline__ const char* bptr(const Unit& u) const { return (const char*)(B + (long)(u.pm / b_div) * b_bs + (long)u.pn * b_pn); }
};
__device__ __forceinline__ GemmB gemm_plain(const bf16_t* A, int lda, const bf16_t* B, int ldb, int K) { GemmB g; g.A = A; g.B = B; g.K = K; g.lda = lda; g.ldb = ldb; g.b_div = 1; g.a_pm = 256L * lda; g.a_pn = 0; g.b_bs = 0; g.b_pn = 256L * ldb; return g; }

__device__ __forceinline__ float bf_lo(unsigned w) { return __uint_as_float(w << 16); }
__device__ __forceinline__ float bf_hi(unsigned w) { return __uint_as_float(w & 0xffff0000u); }
__device__ __forceinline__ float sigmoidf_(float x) { return __builtin_amdgcn_rcpf(1.0f + __expf(-x)); }
__device__ __forceinline__ float gelu_tanh_(float x) { const float z = 1.5957691216057308f * (x + 0.044715f * x * x * x); return x * __builtin_amdgcn_rcpf(1.0f + __expf(-z)); }
__device__ __forceinline__ u32x4 pack8(const f32x4 a, const f32x4 b) { u32x4 w; w.x = cvt_pk_bf16(a[0], a[1]); w.y = cvt_pk_bf16(a[2], a[3]); w.z = cvt_pk_bf16(b[0], b[1]); w.w = cvt_pk_bf16(b[2], b[3]); return w; }

#define EPI_FOR_AI_M _Pragma("unroll") for (int ai = 0; ai < 2; ++ai) _Pragma("unroll") for (int m = 0; m < 4; ++m)
#define EPI_FOR_BJ _Pragma("unroll") for (int bj = 0; bj < 2; ++bj)

struct EpiPlain {
    static constexpr bool PERM = true, AFTER_DRAIN = false;
    bf16_t* O; long ldc; int mode; float scale;
    __device__ __forceinline__ void operator()(const f32x4 (&acc)[2][2][4][2], const Unit& u, int wr, int wc, int fr, int fq) const {
        const int row0 = u.pm * BM + wr * 64 + fr, col0 = u.pn * BM + wc * 32 + 8 * fq;
        EPI_FOR_AI_M { bf16_t* rowp = O + (long)(row0 + ai * HALF + m * 16) * ldc + col0;
            EPI_FOR_BJ { f32x4 v0 = acc[ai][bj][m][0], v1 = acc[ai][bj][m][1];
                if (mode == 1) {
#pragma unroll
                    for (int i = 0; i < 4; ++i) { const float a = fmaxf(v0[i], 0.f), b = fmaxf(v1[i], 0.f); v0[i] = a * a; v1[i] = b * b; }
                } else { v0 = v0 * scale; v1 = v1 * scale; }
                *(u32x4*)(rowp + bj * HALF) = pack8(v0, v1); } }
    }
};
struct EpiF32 {
    static constexpr bool PERM = true, AFTER_DRAIN = false;
    float* O; long ldc;
    __device__ __forceinline__ void operator()(const f32x4 (&acc)[2][2][4][2], const Unit& u, int wr, int wc, int fr, int fq) const {
        const int row0 = u.pm * BM + wr * 64 + fr, col0 = u.pn * BM + wc * 32 + 8 * fq;
        EPI_FOR_AI_M { float* rowp = O + (long)(row0 + ai * HALF + m * 16) * ldc + col0;
            EPI_FOR_BJ { *(f32x4*)(rowp + bj * HALF) = acc[ai][bj][m][0]; *(f32x4*)(rowp + bj * HALF + 4) = acc[ai][bj][m][1]; } }
    }
};
struct EpiInProj {
    static constexpr bool PERM = true, AFTER_DRAIN = false;
    bf16_t* z; long secsz; const float* cosT; const float* sinT; const float* bgate; float qscale;
    __device__ __forceinline__ void operator()(const f32x4 (&acc)[2][2][4][2], const Unit& u, int wr, int wc, int fr, int fq) const {
        const int sec = u.pn >> 2, row0 = u.pm * BM + wr * 64 + fr, col0 = (u.pn & 3) * BM + wc * 32 + 8 * fq;
        bf16_t* base = z + (long)sec * secsz;
        if (sec <= 1) {
            const float sc = sec == 0 ? qscale : 1.0f; const int dp = 16 * (wc & 1) + 4 * fq;
            EPI_FOR_AI_M { const int row = row0 + ai * HALF + m * 16, pos = row & 2047;
                const f32x4 c = *(const f32x4*)(cosT + pos * 32 + dp) * sc, s = *(const f32x4*)(sinT + pos * 32 + dp) * sc;
                EPI_FOR_BJ { const f32x4 v0 = acc[ai][bj][m][0], v1 = acc[ai][bj][m][1]; f32x4 o0, o1;
                    o0[0] = v0[0] * c[0] - v0[1] * s[0]; o0[1] = v0[1] * c[0] + v0[0] * s[0]; o0[2] = v0[2] * c[1] - v0[3] * s[1]; o0[3] = v0[3] * c[1] + v0[2] * s[1];
                    o1[0] = v1[0] * c[2] - v1[1] * s[2]; o1[1] = v1[1] * c[2] + v1[0] * s[2]; o1[2] = v1[2] * c[3] - v1[3] * s[3]; o1[3] = v1[3] * c[3] + v1[2] * s[3];
                    *(u32x4*)(base + (long)row * 1024 + col0 + bj * HALF) = pack8(o0, o1); } }
        } else if (sec >= 6) {
            const float* bg = bgate + (sec - 6) * 1024 + col0;
            EPI_FOR_BJ { const f32x4 b0 = *(const f32x4*)(bg + bj * HALF), b1 = *(const f32x4*)(bg + bj * HALF + 4);
                EPI_FOR_AI_M { f32x4 v0 = acc[ai][bj][m][0] + b0, v1 = acc[ai][bj][m][1] + b1;
#pragma unroll
                    for (int i = 0; i < 4; ++i) { v0[i] = sigmoidf_(v0[i]); v1[i] = sigmoidf_(v1[i]); }
                    *(u32x4*)(base + (long)(row0 + ai * HALF + m * 16) * 1024 + col0 + bj * HALF) = pack8(v0, v1); } }
        } else {
            const float sc = sec == 5 ? 0.0625f : 1.0f;
            EPI_FOR_AI_M { EPI_FOR_BJ { f32x4 v0 = acc[ai][bj][m][0] * sc, v1 = acc[ai][bj][m][1] * sc;
                    if (sec == 4) {
#pragma unroll
                        for (int i = 0; i < 4; ++i) { v0[i] = gelu_tanh_(v0[i]); v1[i] = gelu_tanh_(v1[i]); }
                    }
                    *(u32x4*)(base + (long)(row0 + ai * HALF + m * 16) * 1024 + col0 + bj * HALF) = pack8(v0, v1); } }
        }
    }
};
struct EpiGate {
    static constexpr bool PERM = true, AFTER_DRAIN = false;
    const bf16_t* xc; bf16_t* LA; bf16_t* U; const float* ba; const float* bi; const float* nsp;
    __device__ __forceinline__ void operator()(const f32x4 (&acc)[2][2][4][2], const Unit& u, int wr, int wc, int fr, int fq) const {
        typedef unsigned u32x2 __attribute__((ext_vector_type(2)));
        const int row0 = u.pm * BM + wr * 64 + fr, c0 = u.pn * HALF + wc * 32 + 8 * fq;
#pragma unroll
        for (int hf = 0; hf < 2; ++hf) {
            const f32x4 fba = *(const f32x4*)(ba + c0 + 4 * hf), fbi = *(const f32x4*)(bi + c0 + 4 * hf), fsp = *(const f32x4*)(nsp + c0 + 4 * hf);
            EPI_FOR_AI_M { const long off = (long)(row0 + ai * HALF + m * 16) * 1024 + c0 + 4 * hf;
                const u32x2 xw = *(const u32x2*)(xc + off); const f32x4 xv = {bf_lo(xw.x), bf_hi(xw.x), bf_lo(xw.y), bf_hi(xw.y)};
                f32x4 la, uu;
#pragma unroll
                for (int i = 0; i < 4; ++i) { const float r = sigmoidf_(acc[ai][0][m][hf][i] + fba[i]), ig = sigmoidf_(acc[ai][1][m][hf][i] + fbi[i]); const float l = r * fsp[i]; la[i] = l;
                    const float x2 = 2.0f * l; const float poly = -x2 * (1.0f + x2 * (0.5f + x2 * (0.16666667f + x2 * (0.041666668f + x2 * 0.0083333338f)))); const float om = x2 > -0.5f ? poly : 1.0f - __expf(x2);
                    uu[i] = sqrtf(fmaxf(om, 0.f)) * (ig * xv[i]); }
                u32x2 wl_, wu_; wl_.x = cvt_pk_bf16(la[0], la[1]); wl_.y = cvt_pk_bf16(la[2], la[3]); wu_.x = cvt_pk_bf16(uu[0], uu[1]); wu_.y = cvt_pk_bf16(uu[2], uu[3]);
                *(u32x2*)(LA + off) = wl_; *(u32x2*)(U + off) = wu_; asm volatile("" ::: "memory"); }
        }
    }
};
struct GemmMerge3 { const bf16_t* A0; const bf16_t* A1; const bf16_t* A2; const bf16_t* W0; long wstride; int K, lda, ldb;
    __device__ __forceinline__ const char* aptr(const Unit& u) const { const int br = u.pn >> 2; const bf16_t* A = br == 0 ? A0 : (br == 1 ? A1 : A2); return (const char*)(A + (long)u.pm * 256 * lda); }
    __device__ __forceinline__ const char* bptr(const Unit& u) const { return (const char*)(W0 + (long)(u.pn >> 2) * wstride + (long)(u.pn & 3) * 256 * ldb); }
};
struct MergeOrder { StaticOrder base;
    __device__ __forceinline__ bool next(int i, Unit& u) const { if (i >= 3) return false; Unit t; if (!base.next(0, t)) return false; u.pm = t.pm; u.pn = t.pn + 4 * i; return true; }
    __device__ __forceinline__ void a_ready(const Unit&) const {}
    __device__ __forceinline__ void done(const Unit&) const {}
};
struct EpiMerge3 {
    static constexpr bool PERM = true, AFTER_DRAIN = false;
    const bf16_t* gates; long secsz; float* MF; bf16_t* MB;
    __device__ __forceinline__ void operator()(const f32x4 (&acc)[2][2][4][2], const Unit& u, int wr, int wc, int fr, int fq) const {
        const int br = u.pn >> 2, row0 = u.pm * BM + wr * 64 + fr, col0 = (u.pn & 3) * BM + wc * 32 + 8 * fq; const bf16_t* gate = gates + (long)br * secsz;
        EPI_FOR_AI_M { EPI_FOR_BJ { const long off = (long)(row0 + ai * HALF + m * 16) * 1024 + col0 + bj * HALF;
                const u32x4 gw = *(const u32x4*)(gate + off);
                const f32x4 g0 = {bf_lo(gw.x), bf_hi(gw.x), bf_lo(gw.y), bf_hi(gw.y)}, g1 = {bf_lo(gw.z), bf_hi(gw.z), bf_lo(gw.w), bf_hi(gw.w)};
                f32x4 v0 = acc[ai][bj][m][0] * g0, v1 = acc[ai][bj][m][1] * g1;
                if (br > 0) { v0 = v0 + *(const f32x4*)(MF + off); v1 = v1 + *(const f32x4*)(MF + off + 4); }
                if (br < 2) { *(f32x4*)(MF + off) = v0; *(f32x4*)(MF + off + 4) = v1; }
                else *(u32x4*)(MB + off) = pack8(v0, v1); } }
    }
};
template <int STEP> struct EpiMerge {
    static constexpr bool PERM = true, AFTER_DRAIN = false;
    const bf16_t* gate; float* MF; bf16_t* MB;
    __device__ __forceinline__ void operator()(const f32x4 (&acc)[2][2][4][2], const Unit& u, int wr, int wc, int fr, int fq) const {
        const int row0 = u.pm * BM + wr * 64 + fr, col0 = u.pn * BM + wc * 32 + 8 * fq;
        EPI_FOR_AI_M { EPI_FOR_BJ { const long off = (long)(row0 + ai * HALF + m * 16) * 1024 + col0 + bj * HALF;
                const u32x4 gw = *(const u32x4*)(gate + off);
                const f32x4 g0 = {bf_lo(gw.x), bf_hi(gw.x), bf_lo(gw.y), bf_hi(gw.y)}, g1 = {bf_lo(gw.z), bf_hi(gw.z), bf_lo(gw.w), bf_hi(gw.w)};
                f32x4 v0 = acc[ai][bj][m][0] * g0, v1 = acc[ai][bj][m][1] * g1;
                if (STEP > 0) { v0 = v0 + *(const f32x4*)(MF + off); v1 = v1 + *(const f32x4*)(MF + off + 4); }
                if (STEP < 2) { *(f32x4*)(MF + off) = v0; *(f32x4*)(MF + off + 4) = v1; }
                else *(u32x4*)(MB + off) = pack8(v0, v1); } }
    }
};
template <class Epi, class GemmT, class Sched, bool ALIGN_EPI = true, bool SP2 = true>
__device__ __forceinline__ void gemm_phase(PG8_LAS unsigned char* lds, const GemmT g, const Sched& S, const Epi& E) {
    int tid = threadIdx.x; asm volatile("" : "+v"(tid));
    const int wid = __builtin_amdgcn_readfirstlane(tid >> 6), lane = tid & 63, wr = wid >> 2, wc = wid & 3, fr = lane & 15, fq = lane >> 4;
    int K = g.K; asm volatile("" : "+s"(K));
    const int nt = K / BK;
    unsigned voffA[2], voffB[2];
#pragma unroll
    for (int i = 0; i < 2; ++i) { int R, C; stage_rc(tid * 16 + i * 8192, R, C); const int Rb = Epi::PERM ? ((R & ~31) + perm32(R & 31)) : R;
        voffA[i] = (unsigned)(R * g.lda + C) * 2u; voffB[i] = (unsigned)(Rb * g.ldb + C) * 2u; }
    const size_t kstep = (size_t)(BK * 2);
    const size_t hstepA = (size_t)HALF * g.lda * 2, hstepB = (size_t)HALF * g.ldb * 2;
    const unsigned ldsw = (unsigned)wid * 1024u;
    const int aoff = lds_byte(wr * 64 + fr, fq * 8), boff = lds_byte(wc * 32 + fr, fq * 8);
#define PG8_SA(b, h) (((b) * 2 + (h)) * HTB)
#define PG8_SB(b, h) ((4 + (b) * 2 + (h)) * HTB)
#define PG8_STAGE(bufoff, gbase, voff) do { _Pragma("unroll") for (int _i = 0; _i < 2; ++_i) \
        __builtin_amdgcn_global_load_lds((const unsigned*)((const char*)(gbase) + (voff)[_i]), (PG8_LAS unsigned*)(lds + (bufoff) + ldsw + _i * 8192), 16, 0, 0); } while (0)
#define PG8_LDA(dst, b, h) do { _Pragma("unroll") for (int m = 0; m < 4; ++m) _Pragma("unroll") for (int k = 0; k < 2; ++k) dst[m][k] = *(const PG8_LAS bf16x8*)(lds + PG8_SA(b, h) + aoff + m * 2048 + k * 1024); } while (0)
#define PG8_LDB(dst, b, h) do { _Pragma("unroll") for (int n = 0; n < 2; ++n) _Pragma("unroll") for (int k = 0; k < 2; ++k) dst[n][k] = *(const PG8_LAS bf16x8*)(lds + PG8_SB(b, h) + boff + n * 2048 + k * 1024); } while (0)
#define PG8_MMA(ai, bj, At, Bt) do { __builtin_amdgcn_s_setprio(1); _Pragma("unroll") for (int m = 0; m < 4; ++m) _Pragma("unroll") for (int n = 0; n < 2; ++n) _Pragma("unroll") for (int k = 0; k < 2; ++k) \
        acc[ai][bj][m][n] = __builtin_amdgcn_mfma_f32_16x16x32_bf16(Bt[n][k], At[m][k], acc[ai][bj][m][n], 0, 0, 0); __builtin_amdgcn_s_setprio(0); } while (0)
#define PG8_WAIT_V(n) asm volatile("s_waitcnt vmcnt(" #n ")" ::: "memory")
#define PG8_WAIT_L(n) asm volatile("s_waitcnt lgkmcnt(" #n ")" ::: "memory")
#define PG8_BAR __builtin_amdgcn_s_barrier()
#define PG8_SCHED __builtin_amdgcn_sched_barrier(0)
    Unit cur, nxt; int ui = 0;
    if (!S.next(0, cur)) return;
    f32x4 acc[2][2][4][2];
#pragma unroll
    for (int a = 0; a < 2; ++a)
#pragma unroll
        for (int b = 0; b < 2; ++b)
#pragma unroll
            for (int m = 0; m < 4; ++m)
#pragma unroll
                for (int n = 0; n < 2; ++n) acc[a][b][m][n] = (f32x4){0.f, 0.f, 0.f, 0.f};
    bf16x8 At[4][2], B0[2][2], B1[2][2];
    const char* cA = g.aptr(cur); const char* cB = g.bptr(cur);
    S.a_ready(cur);
    if constexpr (SP2) {
        PG8_STAGE(PG8_SB(0, 0), cB, voffB); PG8_STAGE(PG8_SB(0, 1), cB + hstepB, voffB); PG8_STAGE(PG8_SA(0, 0), cA, voffA); PG8_STAGE(PG8_SA(0, 1), cA + hstepA, voffA);
        if (wr == 1) PG8_BAR;
        PG8_WAIT_V(2); PG8_BAR;
        PG8_STAGE(PG8_SB(1, 0), cB + kstep, voffB); PG8_STAGE(PG8_SA(1, 0), cA + kstep, voffA); PG8_STAGE(PG8_SB(1, 1), cB + hstepB + kstep, voffB);
        PG8_WAIT_V(6); PG8_BAR;
    } else {
        PG8_STAGE(PG8_SB(0, 0), cB, voffB); PG8_STAGE(PG8_SA(0, 0), cA, voffA); PG8_STAGE(PG8_SB(0, 1), cB + hstepB, voffB); PG8_STAGE(PG8_SA(0, 1), cA + hstepA, voffA);
        if (wr == 1) PG8_BAR;
        PG8_WAIT_V(4); PG8_BAR;
        PG8_STAGE(PG8_SB(1, 0), cB + kstep, voffB); PG8_STAGE(PG8_SA(1, 0), cA + kstep, voffA); PG8_STAGE(PG8_SB(1, 1), cB + hstepB + kstep, voffB);
        PG8_WAIT_V(6); PG8_BAR;
    }
    for (;;) {
        const bool has_next = S.next(ui + 1, nxt);
        const char* nA = has_next ? g.aptr(nxt) : cA; const char* nB = has_next ? g.bptr(nxt) : cB;
        for (int t = 0; t < nt; t += 2) {
            const bool last = (t == nt - 2);
            const char* a1 = cA + (size_t)(t + 1) * kstep;
            const char* a2 = last ? nA : cA + (size_t)(t + 2) * kstep; const char* b2 = last ? nB : cB + (size_t)(t + 2) * kstep;
            const char* a3 = a2 + kstep; const char* b3 = b2 + kstep;
            if (last && has_next) S.a_ready(nxt);
            if constexpr (SP2) {
            PG8_LDB(B0, 0, 0); PG8_LDB(B1, 0, 1); PG8_SCHED; PG8_LDA(At, 0, 0); PG8_STAGE(PG8_SA(1, 1), a1 + hstepA, voffA);
            PG8_WAIT_V(8); PG8_WAIT_L(0); PG8_BAR; PG8_MMA(0, 0, At, B0); PG8_MMA(0, 1, At, B1); PG8_BAR; PG8_SCHED;
            PG8_LDA(At, 0, 1); PG8_STAGE(PG8_SB(0, 0), b2, voffB); PG8_STAGE(PG8_SB(0, 1), b2 + hstepB, voffB); PG8_STAGE(PG8_SA(0, 0), a2, voffA);
            PG8_WAIT_V(8); PG8_WAIT_L(0); PG8_BAR; PG8_MMA(1, 0, At, B0); PG8_MMA(1, 1, At, B1); PG8_BAR; PG8_SCHED;
            PG8_LDB(B0, 1, 0); PG8_LDB(B1, 1, 1); PG8_SCHED; PG8_LDA(At, 1, 0); PG8_STAGE(PG8_SA(0, 1), a2 + hstepA, voffA);
            PG8_WAIT_V(8); PG8_WAIT_L(0); PG8_BAR; PG8_MMA(0, 0, At, B0); PG8_MMA(0, 1, At, B1); PG8_BAR; PG8_SCHED;
            PG8_LDA(At, 1, 1); PG8_STAGE(PG8_SB(1, 0), b3, voffB); PG8_STAGE(PG8_SB(1, 1), b3 + hstepB, voffB); PG8_STAGE(PG8_SA(1, 0), a3, voffA);
            PG8_WAIT_V(8); PG8_WAIT_L(0); PG8_BAR; PG8_MMA(1, 0, At, B0); PG8_MMA(1, 1, At, B1); PG8_BAR; PG8_SCHED;
            } else {
            PG8_LDB(B0, 0, 0); PG8_SCHED; PG8_LDA(At, 0, 0); PG8_STAGE(PG8_SA(1, 1), a1 + hstepA, voffA);
            PG8_WAIT_L(8); PG8_BAR; PG8_WAIT_L(0); PG8_MMA(0, 0, At, B0); PG8_BAR; PG8_SCHED;
            PG8_LDB(B1, 0, 1); PG8_STAGE(PG8_SB(0, 0), b2, voffB);
            PG8_BAR; PG8_WAIT_L(0); PG8_MMA(0, 1, At, B1); PG8_BAR;
            PG8_LDA(At, 0, 1); PG8_STAGE(PG8_SA(0, 0), a2, voffA);
            PG8_BAR; PG8_WAIT_L(0); PG8_MMA(1, 0, At, B0); PG8_BAR; PG8_SCHED;
            PG8_STAGE(PG8_SB(0, 1), b2 + hstepB, voffB);
            PG8_WAIT_V(6); PG8_BAR; PG8_MMA(1, 1, At, B1); PG8_BAR;
            PG8_LDB(B0, 1, 0); PG8_SCHED; PG8_LDA(At, 1, 0); PG8_STAGE(PG8_SA(0, 1), a2 + hstepA, voffA);
            PG8_WAIT_L(8); PG8_BAR; PG8_WAIT_L(0); PG8_MMA(0, 0, At, B0); PG8_BAR; PG8_SCHED;
            PG8_LDB(B1, 1, 1); PG8_STAGE(PG8_SB(1, 0), b3, voffB);
            PG8_BAR; PG8_WAIT_L(0); PG8_MMA(0, 1, At, B1); PG8_BAR;
            PG8_LDA(At, 1, 1); PG8_STAGE(PG8_SA(1, 0), a3, voffA);
            PG8_BAR; PG8_WAIT_L(0); PG8_MMA(1, 0, At, B0); PG8_BAR; PG8_SCHED;
            PG8_STAGE(PG8_SB(1, 1), b3 + hstepB, voffB);
            PG8_WAIT_V(6); PG8_BAR; PG8_MMA(1, 1, At, B1); PG8_BAR;
            }
        }
        if constexpr (ALIGN_EPI) { if (wr == 0) PG8_BAR; }
        if constexpr (!Epi::AFTER_DRAIN) { E(acc, cur, wr, wc, fr, fq); S.done(cur); }
        if (!has_next) break;
#pragma unroll
        for (int a = 0; a < 2; ++a)
#pragma unroll
            for (int b = 0; b < 2; ++b)
#pragma unroll
                for (int m = 0; m < 4; ++m)
#pragma unroll
                    for (int n = 0; n < 2; ++n) acc[a][b][m][n] = (f32x4){0.f, 0.f, 0.f, 0.f};
        cur = nxt; cA = nA; cB = nB; ++ui;
        if constexpr (ALIGN_EPI) { if (wr == 1) PG8_BAR; }
    }
    PG8_WAIT_V(0);
    if constexpr (!ALIGN_EPI) { if (wr == 0) PG8_BAR; }
    PG8_BAR;
    if constexpr (Epi::AFTER_DRAIN) { E.fused(acc, cur, wr, wc, fr, fq, lds, wid, lane); S.done(cur); }
#undef PG8_SA
#undef PG8_SB
#undef PG8_STAGE
#undef PG8_LDA
#undef PG8_LDB
#undef PG8_MMA
#undef PG8_WAIT_V
#undef PG8_WAIT_L
#undef PG8_BAR
#undef PG8_SCHED
}
}
#include <hip/hip_bf16.h>
#include <cmath>
namespace attn_body {
using bf16=__hip_bfloat16;
using bf16x8=__attribute__((ext_vector_type(8)))short;
using s16x4=__attribute__((ext_vector_type(4)))short;
using f32x16=__attribute__((ext_vector_type(16)))float;
using u32x4=__attribute__((ext_vector_type(4)))unsigned;
constexpr int SEQ=2048,D=64,DM=1024;
constexpr int NW=8,QBLK=32,QB=QBLK*NW,KVBLK=64,NQB=SEQ/QB;
constexpr int ATTN_PITCH=DM, ATTN_UNIT_ROWS=QB;
__device__ __forceinline__ int crow(int r,int hi){return (r&3)+8*(r>>2)+4*hi;}
#define SBAR() __builtin_amdgcn_sched_barrier(0)
__device__ __forceinline__ void cmask(f32x16&p0,f32x16&p1,int jb,int qrel,int hi){
  const float NEG=-INFINITY; int kb=64*jb+4*hi;
  #pragma unroll
  for(int r=0;r<16;++r){int kv=kb+(r&3)+8*(r>>2); if(kv>qrel)p0[r]=NEG; if(kv+32>qrel)p1[r]=NEG;}
}

constexpr int NSLOT=3, SLOTB=8192;
constexpr int LDS_K=0, LDS_V=NSLOT*SLOTB, LDS_WS=2*NSLOT*SLOTB, LDS_OST=LDS_WS+NW*64*4, LDS_BYTES=LDS_OST+NW*4096;
constexpr float C2=0.125f*1.4426950408889634f;
__device__ __forceinline__ void glds16(const void*gsrc,unsigned lds_dst){unsigned keep;
  asm volatile("s_mov_b32 %0, m0\n\ts_mov_b32 m0, %2\n\ts_nop 0\n\tglobal_load_lds_dwordx4 %1, off\n\ts_mov_b32 m0, %0":"=&s"(keep):"v"(gsrc),"s"(lds_dst):"memory");}
__device__ __forceinline__ float max3f(float a,float b,float c){float r;asm("v_max3_f32 %0, %1, %2, %3":"=v"(r):"v"(a),"v"(b),"v"(c));return r;}
__device__ __forceinline__ float max2f(float a,float b){float r;asm("v_max_f32_e32 %0, %1, %2":"=v"(r):"v"(a),"v"(b));return r;}
__device__ __forceinline__ float fadd_s(float a,float b){float r;asm("v_add_f32_e32 %0, %1, %2":"=v"(r):"v"(a),"v"(b));return r;}
__device__ __forceinline__ float fsub_s(float a,float b){float r;asm("v_sub_f32_e32 %0, %1, %2":"=v"(r):"v"(a),"v"(b));return r;}
typedef float f32x2_t __attribute__((ext_vector_type(2))); typedef __bf16 bf16x2_t __attribute__((ext_vector_type(2)));
__device__ __forceinline__ unsigned cvtpk_s(float lo,float hi){f32x2_t v={lo,hi};bf16x2_t b=__builtin_convertvector(v,bf16x2_t);return __builtin_bit_cast(unsigned,b);}
#define WAIT_BAR(N) asm volatile("s_waitcnt vmcnt(" #N ") lgkmcnt(0)\n\ts_barrier":::"memory")

__device__ __forceinline__ void qkt(f32x16&p0,f32x16&p1,const char*Kslot,const bf16x8*qr,const f32x16&negm,int r32,int hi){
  const char*kb=Kslot+hi*1024+r32*16;
  #pragma unroll
  for(int d0=0;d0<4;++d0){
    const bf16x8 b0=*reinterpret_cast<const bf16x8*>(kb+d0*2048);
    const bf16x8 b1=*reinterpret_cast<const bf16x8*>(kb+d0*2048+512);
    if(d0==0){p0=__builtin_amdgcn_mfma_f32_32x32x16_bf16(b0,qr[0],negm,0,0,0);p1=__builtin_amdgcn_mfma_f32_32x32x16_bf16(b1,qr[0],negm,0,0,0);}
    else{p0=__builtin_amdgcn_mfma_f32_32x32x16_bf16(b0,qr[d0],p0,0,0,0);p1=__builtin_amdgcn_mfma_f32_32x32x16_bf16(b1,qr[d0],p1,0,0,0);}}
}
typedef __attribute__((address_space(3))) const char* lds_cptr;
typedef short v4i16_t __attribute__((ext_vector_type(4)));
__device__ __forceinline__ void kload8(bf16x8*kf,lds_cptr kp){
  kf[0]=*(const __attribute__((address_space(3))) bf16x8*)(kp);      kf[1]=*(const __attribute__((address_space(3))) bf16x8*)(kp+512);
  kf[2]=*(const __attribute__((address_space(3))) bf16x8*)(kp+2048); kf[3]=*(const __attribute__((address_space(3))) bf16x8*)(kp+2560);
  kf[4]=*(const __attribute__((address_space(3))) bf16x8*)(kp+4096); kf[5]=*(const __attribute__((address_space(3))) bf16x8*)(kp+4608);
  kf[6]=*(const __attribute__((address_space(3))) bf16x8*)(kp+6144); kf[7]=*(const __attribute__((address_space(3))) bf16x8*)(kp+6656);
}
__device__ __forceinline__ void kload2(bf16x8*kf,lds_cptr kp,int j){ kf[2*j]=*(const __attribute__((address_space(3))) bf16x8*)(kp+j*2048); kf[2*j+1]=*(const __attribute__((address_space(3))) bf16x8*)(kp+j*2048+512); }
__device__ __forceinline__ s16x4 vtr(lds_cptr p){ return __builtin_bit_cast(s16x4,__builtin_amdgcn_ds_read_tr16_b64_v4i16((__attribute__((address_space(3))) v4i16_t*)p)); }
__device__ __forceinline__ float rowmax(const f32x16&p0,const f32x16&p1){
  float a=max3f(p0[0],p0[1],p1[0]),b=max3f(p0[2],p0[3],p1[1]);a=max3f(a,p1[2],p1[3]);
  #pragma unroll
  for(int r=4;r<16;r+=4){a=max3f(a,p0[r],p0[r+1]);b=max3f(b,p0[r+2],p0[r+3]);a=max3f(a,p1[r],p1[r+1]);b=max3f(b,p1[r+2],p1[r+3]);}
  const float m=max2f(a,b);
  auto rr=__builtin_amdgcn_permlane32_swap(__float_as_uint(m),__float_as_uint(m),false,false);
  return max2f(__uint_as_float(rr[0]),__uint_as_float(rr[1]));
}
__device__ __forceinline__ void pv(f32x16*o,int vb,bf16x8 pa0,bf16x8 pa1,bf16x8 pa2,bf16x8 pa3){
  #pragma unroll
  for(int d0=0;d0<2;++d0){s16x4 lo[4],hi[4];
    #pragma unroll
    for(int ks=0;ks<4;++ks){
      asm volatile("ds_read_b64_tr_b16 %0,%1 offset:%c2":"=&v"(lo[ks]):"v"(vb),"i"(d0*4096+ks*1024):"memory");
      asm volatile("ds_read_b64_tr_b16 %0,%1 offset:%c2":"=&v"(hi[ks]):"v"(vb),"i"(d0*4096+ks*1024+512):"memory");}
    asm volatile("s_waitcnt lgkmcnt(0)":::"memory");SBAR();
    #define PK(k) (bf16x8){lo[k][0],lo[k][1],lo[k][2],lo[k][3],hi[k][0],hi[k][1],hi[k][2],hi[k][3]}
    o[d0]=__builtin_amdgcn_mfma_f32_32x32x16_bf16(pa0,PK(0),o[d0],0,0,0);
    o[d0]=__builtin_amdgcn_mfma_f32_32x32x16_bf16(pa1,PK(1),o[d0],0,0,0);
    o[d0]=__builtin_amdgcn_mfma_f32_32x32x16_bf16(pa2,PK(2),o[d0],0,0,0);
    o[d0]=__builtin_amdgcn_mfma_f32_32x32x16_bf16(pa3,PK(3),o[d0],0,0,0);
    #undef PK
  }
}

#ifndef ATTN_STORE16
#define ATTN_STORE16(p,v) (*(u32x4*)(p)=(v))
#endif
template<int THRL> __device__ __forceinline__ void attn_unit(long rowbase,int qc,int kc,int vc,int oc,int qb,const bf16*Q,const bf16*__restrict__ K,const bf16*__restrict__ V,bf16*O,char*shm){
  int tid=threadIdx.x; asm volatile("":"+v"(tid)); const int lane=tid&63,r32=lane&31,hi=lane>>5; const int wid=__builtin_amdgcn_readfirstlane(tid>>6);
  const int q0=qb*QB;
  const bf16*Qw=Q+(rowbase+q0+wid*QBLK)*DM+qc;
  const bf16*Kh=K+rowbase*DM+kc,*Vh=V+rowbase*DM+vc;
  const unsigned lds0=(unsigned)(uintptr_t)shm;
  float*wsf=(float*)(shm+LDS_WS)+wid*64;
  const bf16*ksrc=Kh+(long)lane*DM+wid*8;
  const bf16*vsrc=Vh+(long)(16*(wid&3)+(lane>>2))*DM+(wid>>2)*32+(lane&3)*8;
  const unsigned kdst=lds0+LDS_K+wid*1024, vdst=lds0+LDS_V+wid*1024;
  #define DMA_K(t,slot) glds16(ksrc+(long)(t)*KVBLK*DM,(unsigned)__builtin_amdgcn_readfirstlane(kdst+(slot)))
  #define DMA_V(t,slot) glds16(vsrc+(long)(t)*KVBLK*DM,(unsigned)__builtin_amdgcn_readfirstlane(vdst+(slot)))
  const int vb0=(int)(lds0+LDS_V)+((lane>>4)&1)*32+(lane&3)*8+(4*hi+((lane&15)>>2))*64;
  const char*Kbase=shm+LDS_K; bf16x8 kf[8];
  const lds_cptr shm3=(lds_cptr)shm; const lds_cptr kp0=shm3+LDS_K+hi*1024+r32*16; const lds_cptr vp0=shm3+LDS_V+((lane>>4)&1)*32+(lane&3)*8+(4*hi+((lane&15)>>2))*64;
  const int NT=(q0+QB)/KVBLK;
  DMA_K(0,0);DMA_V(0,0);DMA_K(1,SLOTB);
  bf16x8 qr[4];
  #pragma unroll
  for(int d0=0;d0<4;++d0)qr[d0]=*reinterpret_cast<const bf16x8*>(&Qw[(long)r32*DM+d0*16+hi*8]);
  float mhat=0.f,l_reg=0.f;f32x16 o[2];o[0]=f32x16{};o[1]=f32x16{};f32x16 negm=f32x16{};asm volatile("":"+v"(negm));
  const int qrel=(wid*QBLK+r32)|63;
  #define CMASK(P0,P1,t) do{int jb_=(t)-(NT-4); if(jb_>=0)cmask(P0,P1,jb_,qrel,hi);}while(0)
  bool resc=false;
  #define START(P0,P1) do{ const float rm=rowmax(P0,P1); resc=false; \
    { const float dl=rm; mhat=fadd_s(mhat,dl); \
      _Pragma("unroll") for(int r=0;r<16;++r){P0[r]=fsub_s(P0[r],dl);P1[r]=fsub_s(P1[r],dl);} \
      _Pragma("unroll") for(int r=0;r<16;++r)negm[r]=-mhat; asm volatile("":"+v"(negm)); } \
    _Pragma("unroll") for(int r=0;r<16;++r)P0[r]=__builtin_amdgcn_exp2f(P0[r]); }while(0)
  #define RESC() do{ if(resc){ asm volatile("s_waitcnt lgkmcnt(0)":::"memory"); \
      _Pragma("unroll") for(int d_=0;d_<2;++d_) _Pragma("unroll") for(int r=0;r<16;++r)o[d_][r]*=wsf[crow(r,hi)]; } }while(0)
  f32x16 pA0,pA1,pB0,pB1;
  int sl_prev=0,sl_cur=0,sl_next=SLOTB;
  #define ROT() do{sl_prev=sl_cur;sl_cur=sl_next;sl_next=(sl_next==(NSLOT-1)*SLOTB)?0:sl_next+SLOTB;}while(0)
  DMA_K(2,2*SLOTB);
  WAIT_BAR(3);
  qkt(pA0,pA1,Kbase,qr,negm,r32,hi);asm volatile("s_nop 15\n\ts_nop 7":"+v"(pA0),"+v"(pA1));CMASK(pA0,pA1,0);
  START(pA0,pA1);
  _Pragma("unroll") for(int r=0;r<16;++r)pA1[r]=__builtin_amdgcn_exp2f(pA1[r]);
  WAIT_BAR(0);
  DMA_K(3,0);DMA_V(1,SLOTB);
  ROT();
  kload8(kf,kp0+sl_cur);
  WAIT_BAR(2);
  s16x4 vlo[8],vhi[8]; u32x4 pw0,pw1,pw2,pw3;
  #define PKW(P,B) cvtpk_s(P[B],P[B+1])
  #define PAF(k) __builtin_bit_cast(bf16x8,pw##k)
  #define VFR(i) (bf16x8){vlo[i][0],vlo[i][1],vlo[i][2],vlo[i][3],vhi[i][0],vhi[i][1],vhi[i][2],vhi[i][3]}
  #define PIN(x) asm volatile("":"+v"(x))
  #define MX3(a,b,c) __builtin_fmaxf(__builtin_fmaxf((a),(b)),(c))
  #define GAPA(MF,A0,A1,A2,A3,W0,W1,PW) do{ MF; sacc+=A0; sacc+=A1; sacc+=A2; sacc+=A3; PIN(sacc); W0; W1; PIN(PW); SBAR(); }while(0)
  #define EX(v) __builtin_amdgcn_exp2f(v)
  #define GAPB(MF,X,B) do{ MF; X[B]=EX(X[B]); X[B+1]=EX(X[B+1]); X[B+2]=EX(X[B+2]); X[B+3]=EX(X[B+3]); PIN(X); SBAR(); }while(0)
  #define VRD(i) do{ vlo[i]=vtr(vp_+(((i)>>2)*4096+((i)&3)*1024)); vhi[i]=vtr(vp_+(((i)>>2)*4096+((i)&3)*1024+512)); }while(0)
  #define KRD(G,j) do{ if(G){ kload2(kf,kp0+sl_next,j); SBAR(); } }while(0)
  #define STEP(C0,C1,P0,P1,t,GK,GV,GL) do{ SBAR(); \
    const lds_cptr vp_=vp0+sl_prev; \
    VRD(0); SBAR(); float sacc=(P0[0]+P0[1]); \
    GAPA(C0=__builtin_amdgcn_mfma_f32_32x32x16_bf16(kf[0],qr[0],negm,0,0,0), P0[2],P0[3],P0[4],P0[5],     pw0[0]=PKW(P0,0), pw0[1]=PKW(P0,2), pw0); \
    VRD(4); SBAR(); GAPA(C1=__builtin_amdgcn_mfma_f32_32x32x16_bf16(kf[1],qr[0],negm,0,0,0), P0[6],P0[7],P0[8],P0[9],     pw0[2]=PKW(P0,4), pw0[3]=PKW(P0,6), pw0); \
    VRD(1); SBAR(); GAPA(C0=__builtin_amdgcn_mfma_f32_32x32x16_bf16(kf[2],qr[1],C0,0,0,0),   P0[10],P0[11],P0[12],P0[13], pw1[0]=PKW(P0,8), pw1[1]=PKW(P0,10), pw1); \
    VRD(5); SBAR(); GAPA(C1=__builtin_amdgcn_mfma_f32_32x32x16_bf16(kf[3],qr[1],C1,0,0,0),   P0[14],P0[15],P1[0],P1[1],   pw1[2]=PKW(P0,12),pw1[3]=PKW(P0,14), pw1); \
    VRD(2); SBAR(); GAPA(C0=__builtin_amdgcn_mfma_f32_32x32x16_bf16(kf[4],qr[2],C0,0,0,0),   P1[2],P1[3],P1[4],P1[5],     pw2[0]=PKW(P1,0), pw2[1]=PKW(P1,2), pw2); \
    VRD(6); SBAR(); GAPA(C1=__builtin_amdgcn_mfma_f32_32x32x16_bf16(kf[5],qr[2],C1,0,0,0),   P1[6],P1[7],P1[8],P1[9],     pw2[2]=PKW(P1,4), pw2[3]=PKW(P1,6), pw2); \
    VRD(3); SBAR(); GAPA(C0=__builtin_amdgcn_mfma_f32_32x32x16_bf16(kf[6],qr[3],C0,0,0,0),   P1[10],P1[11],P1[12],P1[13], pw3[0]=PKW(P1,8), pw3[1]=PKW(P1,10), pw3); \
    VRD(7); SBAR(); GAPA(C1=__builtin_amdgcn_mfma_f32_32x32x16_bf16(kf[7],qr[3],C1,0,0,0),   P1[14],P1[15],0.f,0.f,       pw3[2]=PKW(P1,12),pw3[3]=PKW(P1,14), pw3); \
    l_reg+=sacc; \
    if(GK){DMA_K((t)+3,sl_cur);} if(GV){DMA_V((t)+1,sl_next);} \
    CMASK(C0,C1,t); \
    { float a=MX3(C0[0],C0[1],C1[0]),b=MX3(C0[2],C0[3],C1[1]); a=MX3(a,C1[2],C1[3]); \
      _Pragma("unroll") for(int r=4;r<16;r+=4){a=MX3(a,C0[r],C0[r+1]);b=MX3(b,C0[r+2],C0[r+3]);a=MX3(a,C1[r],C1[r+1]);b=MX3(b,C1[r+2],C1[r+3]);} \
      float rm=__builtin_fmaxf(a,b); { auto rr=__builtin_amdgcn_permlane32_swap(__float_as_uint(rm),__float_as_uint(rm),false,false); rm=__builtin_fmaxf(__uint_as_float(rr[0]),__uint_as_float(rr[1])); } \
      resc=false; \
      if(__builtin_expect(__any(rm>(float)THRL),0)){ const float dl=__builtin_fmaxf(rm,0.f); mhat+=dl; \
        _Pragma("unroll") for(int r=0;r<16;++r){C0[r]-=dl;C1[r]-=dl;} \
        _Pragma("unroll") for(int r=0;r<16;++r)negm[r]=-mhat; asm volatile("":"+v"(negm)); \
        const float f=__builtin_amdgcn_exp2f(-dl); l_reg*=f; if(hi==0)wsf[r32]=f; resc=true; } } \
    SBAR(); \
    GAPB(o[0]=__builtin_amdgcn_mfma_f32_32x32x16_bf16(PAF(0),VFR(0),o[0],0,0,0), C0,0); \
    GAPB(o[1]=__builtin_amdgcn_mfma_f32_32x32x16_bf16(PAF(0),VFR(4),o[1],0,0,0), C0,4); \
    KRD(GL,0); GAPB(o[0]=__builtin_amdgcn_mfma_f32_32x32x16_bf16(PAF(1),VFR(1),o[0],0,0,0), C0,8); \
    KRD(GL,1); GAPB(o[1]=__builtin_amdgcn_mfma_f32_32x32x16_bf16(PAF(1),VFR(5),o[1],0,0,0), C0,12); \
    KRD(GL,2); GAPB(o[0]=__builtin_amdgcn_mfma_f32_32x32x16_bf16(PAF(2),VFR(2),o[0],0,0,0), C1,0); \
    KRD(GL,3); GAPB(o[1]=__builtin_amdgcn_mfma_f32_32x32x16_bf16(PAF(2),VFR(6),o[1],0,0,0), C1,4); \
    GAPB(o[0]=__builtin_amdgcn_mfma_f32_32x32x16_bf16(PAF(3),VFR(3),o[0],0,0,0), C1,8); \
    GAPB(o[1]=__builtin_amdgcn_mfma_f32_32x32x16_bf16(PAF(3),VFR(7),o[1],0,0,0), C1,12); \
    }while(0)
  int t=1;
  #undef CMASK
  #define CMASK(P0,P1,t) do{}while(0)
  for(;t+5<NT;t+=2){
    STEP(pB0,pB1,pA0,pA1,t,true,true,true);     WAIT_BAR(2); RESC(); ROT();
    STEP(pA0,pA1,pB0,pB1,t+1,true,true,true);   WAIT_BAR(2); RESC(); ROT();
  }
  #undef CMASK
  #define CMASK(P0,P1,t) do{int jb_=(t)-(NT-4); if(jb_>=0)cmask(P0,P1,jb_,qrel,hi);}while(0)
  #define ENDW(tt) do{ if((tt)+3<NT){WAIT_BAR(2);} else if((tt)+2<NT){WAIT_BAR(1);} else {WAIT_BAR(0);} }while(0)
  for(;t+1<NT;t+=2){
    STEP(pB0,pB1,pA0,pA1,t,(t+3<NT),(t+1<NT),(t+1<NT));       ENDW(t);   RESC(); ROT();
    STEP(pA0,pA1,pB0,pB1,t+1,(t+4<NT),(t+2<NT),(t+2<NT));     ENDW(t+1); RESC(); ROT();
  }
  STEP(pB0,pB1,pA0,pA1,NT-1,false,false,false); RESC();
  { float sacc=pB0[0]+pB0[1]; _Pragma("unroll") for(int r=2;r<16;++r)sacc+=pB0[r]; _Pragma("unroll") for(int r=0;r<16;++r)sacc+=pB1[r]; l_reg+=sacc;
    pw0=(u32x4){PKW(pB0,0),PKW(pB0,2),PKW(pB0,4),PKW(pB0,6)};pw1=(u32x4){PKW(pB0,8),PKW(pB0,10),PKW(pB0,12),PKW(pB0,14)};pw2=(u32x4){PKW(pB1,0),PKW(pB1,2),PKW(pB1,4),PKW(pB1,6)};pw3=(u32x4){PKW(pB1,8),PKW(pB1,10),PKW(pB1,12),PKW(pB1,14)};
    SBAR(); pv(o,vb0+sl_cur,PAF(0),PAF(1),PAF(2),PAF(3)); }
  #undef PKW
  #undef PAF
  #undef VFR
  #undef PIN
  #undef MX3
  #undef GAPA
  #undef GAPB
  #undef EX
  #undef VRD
  #undef KRD
  #undef STEP
  #undef ENDW
  {auto rr=__builtin_amdgcn_permlane32_swap(__float_as_uint(l_reg),__float_as_uint(l_reg),false,false);l_reg=__uint_as_float(rr[0])+__uint_as_float(rr[1]);}
  if(hi==0)wsf[32+r32]=l_reg;asm volatile("s_waitcnt lgkmcnt(0)":::"memory");
  float rli[16];
  #pragma unroll
  for(int r=0;r<16;++r)rli[r]=__builtin_amdgcn_rcpf(wsf[32+crow(r,hi)]);
  bf16*Ow=O+(rowbase+q0+wid*QBLK)*DM+oc;
  { bf16*stg=(bf16*)(shm+LDS_OST)+wid*2048;
    #pragma unroll
    for(int r=0;r<16;++r){const int orow=crow(r,hi);
      #pragma unroll
      for(int d0=0;d0<2;++d0)stg[orow*64+d0*32+r32]=__float2bfloat16(o[d0][r]*rli[r]);}
    asm volatile("s_waitcnt lgkmcnt(0)":::"memory");
    #pragma unroll
    for(int i=0;i<4;++i){const int row=i*8+(lane>>3),ch=lane&7; const u32x4 v=*(const u32x4*)(stg+row*64+ch*8); ATTN_STORE16(Ow+(long)row*DM+ch*8,v);} }
  asm volatile("s_waitcnt lgkmcnt(0)\n\ts_barrier":::"memory");
  #undef DMA_K
  #undef DMA_V
  #undef CMASK
  #undef START
  #undef RESC
  #undef ROT
}
constexpr int ATTN_LDS_BYTES=LDS_BYTES;
#undef SBAR
#undef WAIT_BAR
}
#define GAS __attribute__((address_space(1)))
#define LAS __attribute__((address_space(3)))
typedef unsigned short bf16;
typedef unsigned v4u __attribute__((ext_vector_type(4)));
typedef unsigned v2u __attribute__((ext_vector_type(2)));
typedef float f32x4 __attribute__((ext_vector_type(4)));
using pg8::cvt_pk_bf16; using pg8::bf_lo; using pg8::bf_hi;

constexpr int NWAVES = 8, NTHR = 512;
constexpr int D = 1024, SEQ = 2048, NBATCH = 32, MTOK = NBATCH * SEQ, NGRP = 4, MG = MTOK / NGRP, NIN = 9216, DFF = 4096, MEMROWS = NBATCH * 256, DEPTH = 2;
constexpr float EPS = 1e-6f;
constexpr size_t MiB = 1u << 20;
constexpr size_t WS_COS = 1 * MiB, WS_SIN = WS_COS + 256 * 1024, WS_NSP = WS_SIN + 256 * 1024;
constexpr size_t WS_W = 2 * MiB, WL = 48 * MiB;
constexpr size_t W_IN = 0, W_KV = 18 * MiB, W_PA = 22 * MiB, W_PL = 24 * MiB, W_PM = 26 * MiB, W_OUT = 28 * MiB, W_UP = 30 * MiB, W_DN = 38 * MiB, W_GATE = 46 * MiB;
constexpr size_t WS_MEMN = 98 * MiB, WS_KM = 130 * MiB, WS_VT = 162 * MiB;
constexpr size_t WS_H = 194 * MiB;
constexpr size_t TB = 32 * MiB;
constexpr size_t WS_Z = 322 * MiB;
constexpr size_t WS_O1 = WS_Z + 9 * TB, WS_O2 = WS_O1 + TB, WS_XC = WS_O2 + TB, WS_LA = WS_XC + TB, WS_U = WS_LA + TB, WS_S = WS_U + TB, WS_END = WS_S + 2 * TB;
static_assert(WS_END == 834 * MiB, "ws map");
constexpr int LDS_BYTES = 147456;

__device__ __forceinline__ float wave_sum(float v) {
#pragma unroll
    for (int o = 1; o < 64; o <<= 1) v += __shfl_xor(v, o);
    return v;
}
__device__ __forceinline__ void transpose_item(const float* W, int K, int N, bf16* WT, int row_off, bool ropeperm, LAS float* scr, int item, int lane) {
    const int nblk = N / 32, kb = item / nblk, nb = item % nblk, k0 = 64 * kb, n0 = 32 * nb;
#pragma unroll 8
    for (int i = 0; i < 32; ++i) { const int kk = 2 * i + (lane >> 5); scr[kk * 33 + (lane & 31)] = W[(size_t)(k0 + kk) * N + n0 + (lane & 31)]; }
    asm volatile("s_waitcnt lgkmcnt(0)" ::: "memory");
    const int c = lane & 7;
#pragma unroll
    for (int j = 0; j < 4; ++j) { const int n = (lane >> 3) + 8 * j; const LAS float* s = scr + (8 * c) * 33 + n;
        v4u o; o.x = cvt_pk_bf16(s[0 * 33], s[1 * 33]); o.y = cvt_pk_bf16(s[2 * 33], s[3 * 33]); o.z = cvt_pk_bf16(s[4 * 33], s[5 * 33]); o.w = cvt_pk_bf16(s[6 * 33], s[7 * 33]);
        int nn = n0 + n; if (ropeperm && nn < 2048) nn = (nn & ~63) + 2 * (nn & 31) + ((nn >> 5) & 1);
        *(v4u*)(WT + (size_t)(row_off + nn) * K + k0 + 8 * c) = o; }
    asm volatile("s_waitcnt lgkmcnt(0)" ::: "memory");
}
__device__ __forceinline__ void norm_row(const float* src, const float* g, bf16* dst, int lane) {
    f32x4 v[4]; float s = 0.f;
#pragma unroll
    for (int j = 0; j < 4; ++j) { v[j] = *(const f32x4*)(src + 4 * lane + 256 * j); s += (v[j][0] * v[j][0] + v[j][1] * v[j][1]) + (v[j][2] * v[j][2] + v[j][3] * v[j][3]); }
    const float rstd = 1.0f / sqrtf(wave_sum(s) * (1.0f / D) + EPS);
#pragma unroll
    for (int j = 0; j < 4; ++j) { const f32x4 gg = *(const f32x4*)(g + 4 * lane + 256 * j); const f32x4 o = v[j] * rstd * gg;
        v2u w; w.x = cvt_pk_bf16(o[0], o[1]); w.y = cvt_pk_bf16(o[2], o[3]); *(v2u*)(dst + 4 * lane + 256 * j) = w; }
}
__device__ __forceinline__ void post_row(const float* t, const float* base, const float* gA, float* out, const float* gB, bf16* hrow, int lane) {
    f32x4 v[4]; float s = 0.f;
#pragma unroll
    for (int j = 0; j < 4; ++j) { v[j] = *(const f32x4*)(t + 4 * lane + 256 * j); s += (v[j][0] * v[j][0] + v[j][1] * v[j][1]) + (v[j][2] * v[j][2] + v[j][3] * v[j][3]); }
    const float rstd = 1.0f / sqrtf(wave_sum(s) * (1.0f / D) + EPS); float s2 = 0.f;
#pragma unroll
    for (int j = 0; j < 4; ++j) { const f32x4 gg = *(const f32x4*)(gA + 4 * lane + 256 * j), bb = *(const f32x4*)(base + 4 * lane + 256 * j);
        v[j] = bb + v[j] * rstd * gg; *(f32x4*)(out + 4 * lane + 256 * j) = v[j]; s2 += (v[j][0] * v[j][0] + v[j][1] * v[j][1]) + (v[j][2] * v[j][2] + v[j][3] * v[j][3]); }
    if (hrow) { const float rstd2 = 1.0f / sqrtf(wave_sum(s2) * (1.0f / D) + EPS);
#pragma unroll
        for (int j = 0; j < 4; ++j) { const f32x4 gg = *(const f32x4*)(gB + 4 * lane + 256 * j); const f32x4 o = v[j] * rstd2 * gg;
            v2u w; w.x = cvt_pk_bf16(o[0], o[1]); w.y = cvt_pk_bf16(o[2], o[3]); *(v2u*)(hrow + 4 * lane + 256 * j) = w; } }
}
__device__ __forceinline__ void combine_row(const bf16* o1, const bf16* o2, const float* subln, float lam, float omli, bf16* y, int lane) {
    const v4u a0 = *(const v4u*)(o1 + 16 * lane), a1 = *(const v4u*)(o1 + 16 * lane + 8), b0 = *(const v4u*)(o2 + 16 * lane), b1 = *(const v4u*)(o2 + 16 * lane + 8);
    float d[16]; const unsigned aw[8] = {a0.x, a0.y, a0.z, a0.w, a1.x, a1.y, a1.z, a1.w}, bw[8] = {b0.x, b0.y, b0.z, b0.w, b1.x, b1.y, b1.z, b1.w};
    float s = 0.f;
#pragma unroll
    for (int i = 0; i < 8; ++i) { d[2 * i] = bf_lo(aw[i]) - lam * bf_lo(bw[i]); d[2 * i + 1] = bf_hi(aw[i]) - lam * bf_hi(bw[i]); s += d[2 * i] * d[2 * i] + d[2 * i + 1] * d[2 * i + 1]; }
    s += __shfl_xor(s, 1); s += __shfl_xor(s, 2); s += __shfl_xor(s, 4);
    const float rstd = omli / sqrtf(s * (1.0f / 128.0f) + EPS); const float* gp = subln + 16 * (lane & 7);
    unsigned w[8];
#pragma unroll
    for (int i = 0; i < 8; ++i) w[i] = cvt_pk_bf16(d[2 * i] * rstd * gp[2 * i], d[2 * i + 1] * rstd * gp[2 * i + 1]);
    *(v4u*)(y + 16 * lane) = (v4u){w[0], w[1], w[2], w[3]}; *(v4u*)(y + 16 * lane + 8) = (v4u){w[4], w[5], w[6], w[7]};
}
__device__ __forceinline__ void softmax_row(const float* srow, bf16* prow, int lane) {
    f32x4 v[4]; float mx = -3.0e38f;
#pragma unroll
    for (int j = 0; j < 4; ++j) { v[j] = *(const f32x4*)(srow + 16 * lane + 4 * j); mx = fmaxf(fmaxf(fmaxf(v[j][0], v[j][1]), fmaxf(v[j][2], v[j][3])), mx); }
    mx = fmaxf(mx, __shfl_xor(mx, 1)); mx = fmaxf(mx, __shfl_xor(mx, 2)); mx = fmaxf(mx, __shfl_xor(mx, 4)); mx = fmaxf(mx, __shfl_xor(mx, 8));
    float s = 0.f;
#pragma unroll
    for (int j = 0; j < 4; ++j) {
#pragma unroll
        for (int i = 0; i < 4; ++i) { v[j][i] = __expf(v[j][i] - mx); s += v[j][i]; } }
    s += __shfl_xor(s, 1); s += __shfl_xor(s, 2); s += __shfl_xor(s, 4); s += __shfl_xor(s, 8);
    const float inv = 1.0f / s;
    v4u w0, w1; w0.x = cvt_pk_bf16(v[0][0] * inv, v[0][1] * inv); w0.y = cvt_pk_bf16(v[0][2] * inv, v[0][3] * inv); w0.z = cvt_pk_bf16(v[1][0] * inv, v[1][1] * inv); w0.w = cvt_pk_bf16(v[1][2] * inv, v[1][3] * inv);
    w1.x = cvt_pk_bf16(v[2][0] * inv, v[2][1] * inv); w1.y = cvt_pk_bf16(v[2][2] * inv, v[2][3] * inv); w1.z = cvt_pk_bf16(v[3][0] * inv, v[3][1] * inv); w1.w = cvt_pk_bf16(v[3][2] * inv, v[3][3] * inv);
    *(v4u*)(prow + 16 * lane) = w0; *(v4u*)(prow + 16 * lane + 8) = w1;
}
__device__ __forceinline__ float ld_bf(const bf16* p) { return __uint_as_float((unsigned)(*p) << 16); }
__device__ __forceinline__ bf16 st_bf(float f) { return (bf16)(cvt_pk_bf16(f, 0.f) & 0xffffu); }

typedef GAS unsigned gu32;
#define RLX_AGENT __ATOMIC_RELAXED, __HIP_MEMORY_SCOPE_AGENT
#define XB_TMO      128
#define XB_XCNT(j)  (256  + 64 * (j))
#define XB_XSUB(j)  (1280 + 64 * (j))
#define XB_XGEN(j)  (2304 + 64 * (j))
#define XB_TOP      3328
#define XB_TOPGEN   3392
#define XCD_BAR_WORDS 3456
#define XB_SPIN_CAP (1u << 24)

__device__ __forceinline__ unsigned xb_ld(unsigned* p)              { return __hip_atomic_load(p, __ATOMIC_RELAXED, __HIP_MEMORY_SCOPE_AGENT); }
__device__ __forceinline__ unsigned xb_add(unsigned* p, unsigned v) { return __hip_atomic_fetch_add(p, v, __ATOMIC_RELAXED, __HIP_MEMORY_SCOPE_AGENT); }
__device__ __forceinline__ unsigned xb_xcc_id() { return (unsigned)__builtin_amdgcn_s_getreg((3 << 11) | 20) & 0xFu; }
#define XB_SPIN(cond, bar) do { unsigned _sp = 0; while (cond) { __builtin_amdgcn_s_sleep(1); \
    if ((++_sp & 255u) == 0u) { if (xb_ld(&(bar)[XB_TMO])) break; if (_sp > XB_SPIN_CAP) { atomicAdd(&(bar)[XB_TMO], 1u); break; } } } } while (0)

struct XcdBarrier {
    unsigned* bar; unsigned x;
    volatile LAS unsigned* st;
};

__device__ __forceinline__ XcdBarrier xcd_barrier_post(unsigned* bar, volatile LAS unsigned* st) {
    XcdBarrier b; b.bar = bar; b.x = xb_xcc_id(); b.st = st;
    if (threadIdx.x == 0) (void)xb_add(&bar[XB_XCNT(b.x)], 1u);
    return b;
}
__device__ __forceinline__ void xcd_barrier_complete(unsigned* bar, unsigned x, unsigned& nloc, unsigned& nx) {
    const unsigned G = gridDim.x * gridDim.y * gridDim.z;
    unsigned sum, cnt, mine, sp = 0u;
    for (;;) {
        sum = 0u; cnt = 0u; mine = 0u;
#pragma unroll
        for (unsigned j = 0; j < 16; ++j) { const unsigned c = xb_ld(&bar[XB_XCNT(j)]); sum += c; cnt += (c > 0u) ? 1u : 0u; mine = (j == x) ? c : mine; }
        if (sum == G) break;
        __builtin_amdgcn_s_sleep(1);
        if ((++sp & 255u) == 0u) { if (xb_ld(&bar[XB_TMO])) break; if (sp > XB_SPIN_CAP) { atomicAdd(&bar[XB_TMO], 1u); break; } }
    }
    nloc = mine > 0u ? mine : 1u; nx = cnt > 0u ? cnt : 1u;
}

__device__ __forceinline__ void xcd_barrier(const XcdBarrier& b) {
    asm volatile("s_waitcnt vmcnt(0)" ::: "memory");
    __syncthreads();
    if (threadIdx.x == 0) {
        unsigned* bar = b.bar;
        __builtin_amdgcn_s_waitcnt(0);
        unsigned nloc = b.st[0], nx = b.st[1];
        if (nloc == 0u) { xcd_barrier_complete(bar, b.x, nloc, nx); b.st[0] = nloc; b.st[1] = nx; }
        const unsigned old = xb_add(&bar[XB_XSUB(b.x)], 1u);
        const unsigned gen = old / nloc;
        if (old + 1u == (gen + 1u) * nloc) {
            __builtin_amdgcn_fence(__ATOMIC_RELEASE, "agent");
            asm volatile("s_waitcnt vmcnt(0)" ::: "memory");
            const unsigned og = xb_add(&bar[XB_TOP], 1u);
            const unsigned tg = og / nx;
            if (og + 1u == (tg + 1u) * nx) xb_add(&bar[XB_TOPGEN], 1u);
            else XB_SPIN(xb_ld(&bar[XB_TOPGEN]) == tg, bar);
            __builtin_amdgcn_fence(__ATOMIC_ACQUIRE, "agent");
            xb_add(&bar[XB_XGEN(b.x)], 1u);
            asm volatile("s_waitcnt vmcnt(0)" ::: "memory");
        } else {
            XB_SPIN(xb_ld(&bar[XB_XGEN(b.x)]) == gen, bar);
            __builtin_amdgcn_fence(__ATOMIC_ACQUIRE, "agent");
            asm volatile("s_waitcnt vmcnt(0)" ::: "memory");
        }
    }
    __syncthreads();
}

struct Args { const float* in[28]; float* out; unsigned char* ws; int ph_lo, ph_hi; };

__global__ void __launch_bounds__(NTHR, 2) hybrid_fwd(Args args) {
    extern __shared__ __attribute__((aligned(16))) unsigned char lds[];
    cg::grid_group grid = cg::this_grid();
    LAS unsigned char* ldsl = (LAS unsigned char*)lds;
    const int G = gridDim.x, bx = blockIdx.x, vcu = (G % 8 == 0) ? (bx % 8) * (G / 8) + bx / 8 : bx;
    const int NGW = G * NWAVES;
#define PHASE_IDS() long oz_ = 0; asm volatile("" : "+s"(oz_)); unsigned char* ws = args.ws + oz_;     int tid = threadIdx.x; asm volatile("" : "+v"(tid)); const int lane = tid & 63, wave = __builtin_amdgcn_readfirstlane(tid >> 6), gw = vcu * NWAVES + wave; (void)lane; (void)gw
    const float* x_in = args.in[0]; float* out = args.out;
#define cosT ((const float*)(ws + WS_COS))
#define sinT ((const float*)(ws + WS_SIN))
#define nspT ((float*)(ws + WS_NSP))
#define Hb ((bf16*)(ws + WS_H))
#define Z ((bf16*)(ws + WS_Z))
    constexpr long SECSZ = (long)MG * 1024;
#define ZQ Z
#define ZK (Z + SECSZ)
#define ZV (Z + 2 * SECSZ)
#define ZX (Z + 3 * SECSZ)
#define GZY (Z + 4 * SECSZ)
#define ZXQ (Z + 5 * SECSZ)
#define GATES (Z + 6 * SECSZ)
#define O1 ((bf16*)(ws + WS_O1))
#define O2 ((bf16*)(ws + WS_O2))
#define XC ((bf16*)(ws + WS_XC))
#define LA ((bf16*)(ws + WS_LA))
#define UU ((bf16*)(ws + WS_U))
#define Sf ((float*)(ws + WS_S))
#define YA ZQ
#define YL ZX
#define YM ZXQ
#define Pb ZV
#define MB ZK
#define HID ZQ
#define MF ((float*)(ws + WS_O1))
#define Tf Sf
#define wl (ws + WS_W + (size_t)l * WL)
    const int lo = args.ph_lo, hi = args.ph_hi; int ph = 0;
    { volatile LAS unsigned* MISC0 = (volatile LAS unsigned*)(ldsl + 131072 + 320); if (threadIdx.x < 32) MISC0[threadIdx.x] = 0u; __syncthreads(); }
    const XcdBarrier xbar = xcd_barrier_post((unsigned*)(args.ws) + 4096, (volatile LAS unsigned*)(ldsl + 131072 + 320) + 8);
#ifndef PHMASK
#define PHMASK 0xffffffffu
#endif
#define IN_PH() (lo <= ph && ph < hi)
#define SEAM_CG() do { if (lo <= ph && ph + 1 < hi) grid.sync(); ++ph; } while (0)
#define SEAM() do { if (lo <= ph && ph + 1 < hi) xcd_barrier(xbar); ++ph; } while (0)
#define WG_SYNC() __syncthreads()

    if (IN_PH() && ((PHMASK >> 0) & 1)) {
                PHASE_IDS();
        LAS float* scr = (LAS float*)(ldsl + wave * 16384);
        constexpr int I_IN = 16 * (NIN / 32), I_KV = 16 * 64, I_SQ = 16 * 32, I_UP = 16 * 128, I_DN = 64 * 32, I_G = 8, I_L = I_IN + I_KV + 4 * I_SQ + I_UP + I_DN + 16 * I_G;
        for (int it = gw; it < DEPTH * I_L; it += NGW) {
            const int l = it / I_L; int r = it % I_L;
            if (r < I_IN) { transpose_item(args.in[7] + (size_t)l * D * NIN, D, NIN, (bf16*)(wl + W_IN), 0, true, scr, r, lane); continue; } r -= I_IN;
            if (r < I_KV) { transpose_item(args.in[21] + (size_t)l * D * 2048, D, 2048, (bf16*)(wl + W_KV), 0, false, scr, r, lane); continue; } r -= I_KV;
            if (r < I_SQ) { transpose_item(args.in[22] + (size_t)l * D * D, D, D, (bf16*)(wl + W_PA), 0, false, scr, r, lane); continue; } r -= I_SQ;
            if (r < I_SQ) { transpose_item(args.in[23] + (size_t)l * D * D, D, D, (bf16*)(wl + W_PL), 0, false, scr, r, lane); continue; } r -= I_SQ;
            if (r < I_SQ) { transpose_item(args.in[24] + (size_t)l * D * D, D, D, (bf16*)(wl + W_PM), 0, false, scr, r, lane); continue; } r -= I_SQ;
            if (r < I_SQ) { transpose_item(args.in[25] + (size_t)l * D * D, D, D, (bf16*)(wl + W_OUT), 0, false, scr, r, lane); continue; } r -= I_SQ;
            if (r < I_UP) { transpose_item(args.in[26] + (size_t)l * D * DFF, D, DFF, (bf16*)(wl + W_UP), 0, false, scr, r, lane); continue; } r -= I_UP;
            if (r < I_DN) { transpose_item(args.in[27] + (size_t)l * DFF * D, DFF, D, (bf16*)(wl + W_DN), 0, false, scr, r, lane); continue; } r -= I_DN;
            { const int mat = r / I_G, n = mat >> 1, which = mat & 1;
              transpose_item(args.in[which ? 18 : 16] + (size_t)l * 8 * 128 * 128 + (size_t)n * 128 * 128, 128, 128, (bf16*)(wl + W_GATE), n * 256 + which * 128, false, scr, r % I_G, lane); }
        }
        for (int i = bx * NTHR + tid; i < SEQ * 32; i += G * NTHR) {
            const int pos = i >> 5, dd = i & 31; const float inv = 1.0f / exp2f((float)dd * (13.287712379549449f / 32.0f)); const float ang = (float)pos * inv;
            const double a = (double)ang, rr = a - 6.283185307179586 * __builtin_rint(a * 0.15915494309189535); const float rf = (float)rr;
            ((float*)(ws + WS_COS))[i] = __cosf(rf); ((float*)(ws + WS_SIN))[i] = __sinf(rf);
        }
        for (int i = bx * NTHR + tid; i < DEPTH * D; i += G * NTHR) nspT[i] = -8.0f * log1pf(__expf(-args.in[20][i]));
        for (int m = gw; m < DEPTH * MEMROWS; m += NGW) { const int l = m / MEMROWS, r = m % MEMROWS; norm_row(args.in[1] + (size_t)r * D, args.in[6] + l * D, (bf16*)(ws + WS_MEMN + (size_t)l * 16 * MiB) + (size_t)r * D, lane); }
        for (int m = gw; m < MTOK; m += NGW) norm_row(x_in + (size_t)m * D, args.in[2], Hb + (size_t)m * D, lane);
    }
    SEAM_CG();
    if (IN_PH() && ((PHMASK >> 1) & 1)) {
                PHASE_IDS();
#pragma unroll 1
        for (int l = 0; l < DEPTH; ++l) {
            const bf16* wkv = (const bf16*)(ws + WS_W + (size_t)l * WL + W_KV); const bf16* memn = (const bf16*)(ws + WS_MEMN + (size_t)l * 16 * MiB);
            { pg8::GemmB g = pg8::gemm_plain(memn, D, wkv, D, D); pg8::StaticOrder S; S.init(MEMROWS, 1024, G, bx); pg8::EpiPlain E{(bf16*)(ws + WS_KM + (size_t)l * 16 * MiB), 1024, 0, 1.0f};
              pg8::gemm_phase<pg8::EpiPlain, pg8::GemmB, pg8::StaticOrder>(ldsl, g, S, E); }
            { pg8::GemmB g = pg8::gemm_plain(wkv + (size_t)1024 * D, D, memn, D, D); pg8::StaticOrder S; S.init(1024, MEMROWS, G, bx); pg8::EpiPlain E{(bf16*)(ws + WS_VT + (size_t)l * 16 * MiB), MEMROWS, 0, 1.0f};
              pg8::gemm_phase<pg8::EpiPlain, pg8::GemmB, pg8::StaticOrder>(ldsl, g, S, E); }
        }
    }
    SEAM();
#pragma unroll 1
    for (int l = 0; l < DEPTH; ++l) {
        const float lam_init = l == 0 ? 0.2f : 0.35550906759096924f;
#pragma unroll 1
        for (int grp = 0; grp < NGRP; ++grp) {
            const size_t grow = (size_t)grp * MG;
            if (IN_PH() && ((PHMASK >> 2) & 1)) {
                PHASE_IDS();
                pg8::GemmB g = pg8::gemm_plain(Hb + grow * D, D, (const bf16*)(wl + W_IN), D, D); pg8::StaticOrder S; S.init(MG, NIN, G, bx);
                pg8::EpiInProj E{Z, SECSZ, cosT, sinT, args.in[8] + l * 3 * D, 0.125f * 1.4426950408889634f};
                pg8::gemm_phase<pg8::EpiInProj, pg8::GemmB, pg8::StaticOrder>(ldsl, g, S, E);
            }
            SEAM();
            if (IN_PH() && ((PHMASK >> 3) & 1)) {
                PHASE_IDS();
#ifndef NO_ATTN
                for (int unit = vcu; unit < 256; unit += G) {
                    const int b = unit >> 5, vh = unit & 31, h = vh >> 2, j = (vh >> 1) & 1, e = vh & 1;
#pragma unroll 1
                    for (int qb = 7; qb >= 0; --qb)
                        attn_body::attn_unit<8>((long)b * SEQ, h * 128 + j * 64, h * 128 + j * 64, h * 128 + e * 64, h * 128 + e * 64, qb,
                                                (const attn_body::bf16*)ZQ, (const attn_body::bf16*)ZK, (const attn_body::bf16*)ZV, (attn_body::bf16*)(j ? O2 : O1), (char*)lds);
                }
#endif
                WG_SYNC();
                { const float* cw = args.in[14] + l * 4 * D; const float* cb = args.in[15] + l * D;
                  for (int idx = bx * NTHR + tid; idx < MG * 128; idx += G * NTHR) {
                      const int row = idx >> 7, ch = (idx & 127) * 8, pos = row & (SEQ - 1);
                      float a[8];
#pragma unroll
                      for (int i = 0; i < 8; ++i) a[i] = cb[ch + i];
#pragma unroll
                      for (int k = 0; k < 4; ++k) if (pos - 3 + k >= 0) {
                          const v4u xw = *(const v4u*)(ZX + (size_t)(row - 3 + k) * D + ch); const f32x4 w0 = *(const f32x4*)(cw + k * D + ch), w1 = *(const f32x4*)(cw + k * D + ch + 4);
                          a[0] += bf_lo(xw.x) * w0[0]; a[1] += bf_hi(xw.x) * w0[1]; a[2] += bf_lo(xw.y) * w0[2]; a[3] += bf_hi(xw.y) * w0[3];
                          a[4] += bf_lo(xw.z) * w1[0]; a[5] += bf_hi(xw.z) * w1[1]; a[6] += bf_lo(xw.w) * w1[2]; a[7] += bf_hi(xw.w) * w1[3]; }
                      v4u o; o.x = cvt_pk_bf16(a[0], a[1]); o.y = cvt_pk_bf16(a[2], a[3]); o.z = cvt_pk_bf16(a[4], a[5]); o.w = cvt_pk_bf16(a[6], a[7]);
                      *(v4u*)(XC + (size_t)row * D + ch) = o; } }
                WG_SYNC();
                { pg8::GemmB g; g.A = ZXQ; g.B = (const bf16*)(ws + WS_KM + (size_t)l * 16 * MiB) + (size_t)grp * 8 * 256 * 1024; g.K = 256; g.lda = 1024; g.ldb = 1024; g.b_div = 8;
                  g.a_pm = 256L * 1024; g.a_pn = 256; g.b_bs = 256L * 1024; g.b_pn = 256;
                  pg8::StaticOrder S; S.init(MG, 1024, G, bx); pg8::EpiF32 E{Sf, 1024};
                  pg8::gemm_phase<pg8::EpiF32, pg8::GemmB, pg8::StaticOrder>(ldsl, g, S, E); }
            }
            SEAM();
            if (IN_PH() && ((PHMASK >> 4) & 1)) {
                PHASE_IDS();
                float lam;
                { const float p1 = args.in[9][l * 64 + lane] * args.in[10][l * 64 + lane], p2 = args.in[11][l * 64 + lane] * args.in[12][l * 64 + lane];
                  lam = __expf(wave_sum(p1)) - __expf(wave_sum(p2)) + lam_init; }
                const float* subln = args.in[13] + l * 128;
                for (int m = gw; m < MG; m += NGW) { combine_row(O1 + (size_t)m * D, O2 + (size_t)m * D, subln, lam, 1.0f - lam_init, YA + (size_t)m * D, lane);
                                                     softmax_row(Sf + (size_t)m * D, Pb + (size_t)m * D, lane); }
                WG_SYNC();
                { pg8::GemmB g; g.A = XC; g.B = (const bf16*)(wl + W_GATE); g.K = 128; g.lda = 1024; g.ldb = 128; g.b_div = 1; g.a_pm = 256L * 1024; g.a_pn = 128; g.b_bs = 0; g.b_pn = 256L * 128;
                  pg8::StaticOrder S; S.init(MG, 2048, G, bx); pg8::EpiGate E{XC, LA, UU, args.in[17] + l * D, args.in[19] + l * D, nspT + l * D};
                  pg8::gemm_phase<pg8::EpiGate, pg8::GemmB, pg8::StaticOrder>(ldsl, g, S, E); }
            }
            SEAM();
            if (IN_PH() && ((PHMASK >> 5) & 1)) {
                PHASE_IDS();
                LAS float* sP = (LAS float*)ldsl; LAS float* sH = sP + 4096;
                for (int unit = vcu; unit < 256; unit += G) {
                    const int b = unit >> 5, cb = unit & 31, cq = tid & 3, chunk = tid >> 2;
                    const size_t i0 = ((size_t)b * SEQ + (size_t)chunk * 16) * D + cb * 32 + cq * 8;
                    float hh[8], As[8];
#pragma unroll
                    for (int c = 0; c < 8; ++c) { hh[c] = 0.f; As[c] = 0.f; }
#pragma unroll 8
                    for (int t = 0; t < 16; ++t) { const v4u lw = *(const v4u*)(LA + i0 + (size_t)t * D), uw = *(const v4u*)(UU + i0 + (size_t)t * D);
                        const unsigned lww[4] = {lw.x, lw.y, lw.z, lw.w}, uww[4] = {uw.x, uw.y, uw.z, uw.w};
#pragma unroll
                        for (int c = 0; c < 4; ++c) { const float l0 = bf_lo(lww[c]), l1 = bf_hi(lww[c]); hh[2 * c] = __expf(l0) * hh[2 * c] + bf_lo(uww[c]); hh[2 * c + 1] = __expf(l1) * hh[2 * c + 1] + bf_hi(uww[c]); As[2 * c] += l0; As[2 * c + 1] += l1; } }
#pragma unroll
                    for (int c = 0; c < 8; ++c) { sP[chunk * 32 + cq * 8 + c] = __expf(As[c]); sH[chunk * 32 + cq * 8 + c] = hh[c]; }
                    WG_SYNC();
#pragma unroll
                    for (int c = 0; c < 8; ++c) hh[c] = 0.f;
                    for (int k = 0; k < chunk; ++k) {
#pragma unroll
                        for (int c = 0; c < 8; ++c) hh[c] = sP[k * 32 + cq * 8 + c] * hh[c] + sH[k * 32 + cq * 8 + c]; }
#pragma unroll 8
                    for (int t = 0; t < 16; ++t) { const size_t ii = i0 + (size_t)t * D; const v4u lw = *(const v4u*)(LA + ii), uw = *(const v4u*)(UU + ii), gw = *(const v4u*)(GZY + ii);
                        const unsigned lww[4] = {lw.x, lw.y, lw.z, lw.w}, uww[4] = {uw.x, uw.y, uw.z, uw.w}, gww[4] = {gw.x, gw.y, gw.z, gw.w}; unsigned ow[4];
#pragma unroll
                        for (int c = 0; c < 4; ++c) { hh[2 * c] = __expf(bf_lo(lww[c])) * hh[2 * c] + bf_lo(uww[c]); hh[2 * c + 1] = __expf(bf_hi(lww[c])) * hh[2 * c + 1] + bf_hi(uww[c]);
                            ow[c] = cvt_pk_bf16(hh[2 * c] * bf_lo(gww[c]), hh[2 * c + 1] * bf_hi(gww[c])); }
                        *(v4u*)(YL + ii) = (v4u){ow[0], ow[1], ow[2], ow[3]}; }
                    WG_SYNC();
                }
                { pg8::GemmB g; g.A = Pb; g.B = (const bf16*)(ws + WS_VT + (size_t)l * 16 * MiB) + (size_t)grp * 8 * 256; g.K = 256; g.lda = 1024; g.ldb = MEMROWS; g.b_div = 8;
                  g.a_pm = 256L * 1024; g.a_pn = 256; g.b_bs = 256; g.b_pn = 256L * MEMROWS;
                  pg8::StaticOrder S; S.init(MG, 1024, G, bx); pg8::EpiPlain E{YM, 1024, 0, 1.0f};
                  pg8::gemm_phase<pg8::EpiPlain, pg8::GemmB, pg8::StaticOrder>(ldsl, g, S, E); }
            }
            SEAM();
            if (IN_PH() && ((PHMASK >> 6) & 1)) {
                PHASE_IDS();
                pg8::MergeOrder S; S.base.init(MG, 1024, G, bx);
                pg8::GemmMerge3 g{YA, YL, YM, (const bf16*)(wl + W_PA), (long)D * D, D, D, D}; pg8::EpiMerge3 E{GATES, SECSZ, MF, MB};
                pg8::gemm_phase<pg8::EpiMerge3, pg8::GemmMerge3, pg8::MergeOrder>(ldsl, g, S, E);
            }
            SEAM();
            if (IN_PH() && ((PHMASK >> 7) & 1)) {
                PHASE_IDS();
                pg8::GemmB g = pg8::gemm_plain(MB, D, (const bf16*)(wl + W_OUT), D, D); pg8::StaticOrder S; S.init(MG, 1024, G, bx); pg8::EpiF32 E{Tf, 1024};
                pg8::gemm_phase<pg8::EpiF32, pg8::GemmB, pg8::StaticOrder>(ldsl, g, S, E);
            }
            SEAM();
            if (IN_PH() && ((PHMASK >> 8) & 1)) {
                PHASE_IDS();
                const float* base = (l == 0 ? x_in : out) + grow * D;
                for (int m = gw; m < MG; m += NGW) post_row(Tf + (size_t)m * D, base + (size_t)m * D, args.in[3] + l * D, out + (grow + m) * D, args.in[4] + l * D, Hb + (grow + m) * D, lane);
            }
            SEAM();
            if (IN_PH() && ((PHMASK >> 9) & 1)) {
                PHASE_IDS();
                pg8::GemmB g = pg8::gemm_plain(Hb + grow * D, D, (const bf16*)(wl + W_UP), D, D); pg8::StaticOrder S; S.init(MG, DFF, G, bx); pg8::EpiPlain E{HID, DFF, 1, 1.0f};
                pg8::gemm_phase<pg8::EpiPlain, pg8::GemmB, pg8::StaticOrder>(ldsl, g, S, E);
            }
            SEAM();
            if (IN_PH() && ((PHMASK >> 10) & 1)) {
                PHASE_IDS();
                pg8::GemmB g = pg8::gemm_plain(HID, DFF, (const bf16*)(wl + W_DN), DFF, DFF); pg8::StaticOrder S; S.init(MG, 1024, G, bx); pg8::EpiF32 E{Tf, 1024};
                pg8::gemm_phase<pg8::EpiF32, pg8::GemmB, pg8::StaticOrder>(ldsl, g, S, E);
            }
            SEAM();
            if (IN_PH() && ((PHMASK >> 11) & 1)) {
                PHASE_IDS();
                const bool more = (l + 1 < DEPTH);
                for (int m = gw; m < MG; m += NGW) post_row(Tf + (size_t)m * D, out + (grow + m) * D, args.in[5] + l * D, out + (grow + m) * D, more ? args.in[2] + (l + 1) * D : nullptr, more ? Hb + (grow + m) * D : nullptr, lane);
            }
            SEAM();
#ifdef DUMP_AT
            if (ph > DUMP_AT) break;
#endif
        }
#ifdef DUMP_AT
        if (ph > DUMP_AT) break;
#endif
    }
#ifdef DUMP_AT
    {
        xcd_barrier(xbar);
        unsigned char* ws = args.ws;
        const bf16* src[4] = {DUMP_B0, DUMP_B1, DUMP_B2, DUMP_B3};
        for (long i = (long)blockIdx.x * NTHR + threadIdx.x; i < 4L * MG * 1024; i += (long)G * NTHR) { const int q = (int)(i / ((long)MG * 1024)); const long r = i % ((long)MG * 1024);
            const bf16* p = q == 0 ? src[0] : q == 1 ? src[1] : q == 2 ? src[2] : src[3]; out[i] = ld_bf(p + r); }
    }
#endif
}

extern "C" void kernel_launch(void* const* d_in, const int* in_sizes, int n_in, void* d_out, int out_size, void* d_ws, size_t ws_size, hipStream_t stream) {
    static int grid = 0;
    if (grid == 0) {
        if (n_in != 28 || out_size != MTOK * D || ws_size < WS_END) { fprintf(stderr, "kernel_launch: unexpected shapes: n_in %d out %d ws %zu (need %zu)\n", n_in, out_size, ws_size, (size_t)WS_END); grid = -1; return; }
        int dev = 0, cus = 0, per_cu = 0;
        if (hipGetDevice(&dev) != hipSuccess || hipDeviceGetAttribute(&cus, hipDeviceAttributeMultiprocessorCount, dev) != hipSuccess) { grid = -1; return; }
        if (hipFuncSetAttribute((const void*)hybrid_fwd, hipFuncAttributeMaxDynamicSharedMemorySize, LDS_BYTES) != hipSuccess) { fprintf(stderr, "kernel_launch: hipFuncSetAttribute failed\n"); grid = -1; return; }
        if (hipOccupancyMaxActiveBlocksPerMultiprocessor(&per_cu, (const void*)hybrid_fwd, NTHR, LDS_BYTES) != hipSuccess || per_cu < 1) { fprintf(stderr, "kernel_launch: occupancy query says %d\n", per_cu); }
        (void)hipGetLastError();
        grid = cus;
    }
    if (grid < 0) return;
    if (hipMemsetAsync(d_ws, 0, 1u << 20, stream) != hipSuccess) { fprintf(stderr, "kernel_launch: memset failed\n"); return; }
    Args a{};
    for (int i = 0; i < 28; ++i) a.in[i] = (const float*)d_in[i];
    a.out = (float*)d_out; a.ws = (unsigned char*)d_ws; a.ph_lo = 0; a.ph_hi = 1 << 20;
#ifdef DUMP_AT
    a.ph_hi = DUMP_AT + 1;
#endif
    void* kargs[] = {&a};
    hipError_t e = hipLaunchCooperativeKernel((const void*)hybrid_fwd, dim3(grid), dim3(NTHR), kargs, LDS_BYTES, stream);
    if (e != hipSuccess) fprintf(stderr, "kernel_launch: cooperative launch failed: %s (grid %d)\n", hipGetErrorString(e), grid);
}
```
